# Optimizing an MI355X kernel written in HIP

```python
import math
import jax, jax.numpy as jnp
from jax import lax
import numpy as np

D_MODEL = 2048
BATCH = 8
SEQ = 2048
DEPTH = 2

BRANCH_WIDTH = D_MODEL
A_WIDTH = BRANCH_WIDTH
A_GROUPS = 8
A_CHUNK = 128
B_HEAD_DIM = 128
B_HEADS = BRANCH_WIDTH // B_HEAD_DIM
B_KV_GROUPS = 4
B_WIDTH = B_HEADS * B_HEAD_DIM
KV_WIDTH = B_KV_GROUPS * B_HEAD_DIM
CMP_BLOCK = 32
CMP_STRIDE = 16
SEL_BLOCK = 64
N_SELECT = 16
WINDOW = 512
NSA_QBLOCK = 64
FORCE_BONUS = 1e4
C_WIDTH = BRANCH_WIDTH
POOL_WINDOWS = (2, 4, 8, 16)
C_GROUP = C_WIDTH // len(POOL_WINDOWS)
REL_BUCKETS = 32
REL_MAX_DIST = 128
EPS = 1e-6
NEG_INF = -1e30

IN_SIZES = (A_WIDTH, A_WIDTH, A_WIDTH,
            B_WIDTH, 6 * KV_WIDTH, 3 * B_HEADS, B_WIDTH,
            C_WIDTH, C_WIDTH,
            3 * D_MODEL)
IN_SPLITS = tuple(int(v) for v in np.cumsum(IN_SIZES)[:-1])
N_IN_COLS = int(sum(IN_SIZES))

kernel_name = 'hybrid_gmlp_nsa_pool_adaln'


def rmsnorm(x, g):
    xf = x.astype(jnp.float32)
    y = xf * lax.rsqrt(jnp.mean(xf * xf, axis=-1, keepdims=True) + EPS)
    return (y * g).astype(x.dtype)


def layernorm(x, g, b):
    xf = x.astype(jnp.float32)
    mu = jnp.mean(xf, axis=-1, keepdims=True)
    var = jnp.mean((xf - mu) ** 2, axis=-1, keepdims=True)
    return ((xf - mu) * lax.rsqrt(var + EPS) * g + b).astype(x.dtype)


def masked_softmax(s, mask):
    s = jnp.where(mask, s.astype(jnp.float32), NEG_INF)
    return jnp.where(mask, jax.nn.softmax(s, axis=-1), 0.0)


def t5_bucket(n):
    max_exact = REL_BUCKETS // 2
    nf = jnp.maximum(n, 1).astype(jnp.float32)
    large = max_exact + (jnp.log(nf / max_exact) / math.log(REL_MAX_DIST / max_exact)
                         * (REL_BUCKETS - max_exact)).astype(jnp.int32)
    large = jnp.minimum(large, REL_BUCKETS - 1)
    return jnp.where(n < max_exact, n, large)


def chunked_sgu(u, v, gate, ln_g, ln_b, w_s, b_s, w_proj):
    bsz, s_len, _ = u.shape
    u = jax.nn.gelu(u)
    v = layernorm(jax.nn.gelu(v), ln_g, ln_b)
    v = v.reshape(bsz, s_len // A_CHUNK, A_CHUNK, A_GROUPS, A_WIDTH // A_GROUPS)
    tri = jnp.tril(jnp.ones((A_CHUNK, A_CHUNK), dtype=bool))
    ws = jnp.where(tri[None], w_s, 0.0)
    mixed = jnp.einsum('gts,bnsgc->bntgc', ws, v) + b_s.T[:, :, None]
    y = u * mixed.reshape(bsz, s_len, A_WIDTH) * jax.nn.silu(gate)
    return y @ w_proj


def multiscale_pool(xc, gate, w_grp, ls, w_proj):
    bsz, s_len, _ = xc.shape
    xf = xc.astype(jnp.float32)
    cs = jnp.concatenate([jnp.zeros((bsz, 1, C_WIDTH), jnp.float32),
                          jnp.cumsum(xf, axis=1)], axis=1)
    t = jnp.arange(s_len)
    outs = []
    for gi, w in enumerate(POOL_WINDOWS):
        lo = jnp.maximum(t + 1 - w, 0)
        cnt = (t + 1 - lo).astype(jnp.float32)
        sl = slice(gi * C_GROUP, (gi + 1) * C_GROUP)
        mean = (cs[:, 1:, sl] - cs[:, lo, sl]) / cnt[None, :, None]
        outs.append(mean - xf[:, :, sl])
    y = jnp.stack(outs, axis=2).astype(xc.dtype)
    y = jnp.einsum('bsgc,gcd->bsgd', y, w_grp).reshape(bsz, s_len, C_WIDTH) * ls
    return (y * jax.nn.silu(gate)) @ w_proj


def native_sparse_attention(q, kv, gsel, gate, w_cmp1, w_cmp2, pos_cmp, rel_bias, w_proj):
    bsz, s_len, _ = q.shape
    G, dh = B_KV_GROUPS, B_HEAD_DIM
    hg = B_HEADS // G
    scale = dh ** -0.5
    q = q.reshape(bsz, s_len, G, hg, dh).transpose(0, 2, 3, 1, 4)
    kv = kv.reshape(bsz, s_len, 6, G, dh).transpose(2, 0, 3, 1, 4)
    k_c, v_c, k_s, v_s, k_w, v_w = kv[0], kv[1], kv[2], kv[3], kv[4], kv[5]
    gsel = jax.nn.sigmoid(gsel.reshape(bsz, s_len, 3, G, hg)).transpose(2, 0, 3, 4, 1)

    ratio = CMP_BLOCK // CMP_STRIDE
    n_cmp = s_len // CMP_STRIDE - ratio + 1

    def compress(k, i):
        ch = k.reshape(bsz, G, s_len // CMP_STRIDE, CMP_STRIDE, dh)
        blk = jnp.concatenate([ch[:, :, j:j + n_cmp] for j in range(ratio)], axis=3) + pos_cmp[i]
        hdn = jax.nn.gelu(jnp.einsum('bgnld,lde->bgne', blk, w_cmp1[i]))
        return hdn @ w_cmp2[i]

    kc = compress(k_c, 0)
    vc = compress(v_c, 1)
    cmp_end = jnp.arange(n_cmp) * CMP_STRIDE + CMP_BLOCK - 1

    n_sel = s_len // SEL_BLOCK
    k_top = min(N_SELECT, n_sel)
    cst = np.arange(n_cmp) * CMP_STRIDE
    sst = np.arange(n_sel) * SEL_BLOCK
    overlap = jnp.asarray(((cst[:, None] < sst[None] + SEL_BLOCK) &
                           (cst[:, None] + CMP_BLOCK > sst[None])).astype(np.float32))
    ks_blk = k_s.reshape(bsz, G, n_sel, SEL_BLOCK, dh)
    vs_blk = v_s.reshape(bsz, G, n_sel, SEL_BLOCK, dh)
    sidx = jnp.arange(n_sel)
    gather_blocks = jax.vmap(jax.vmap(lambda kb, i: kb[i]))

    pad = jnp.zeros((bsz, G, WINDOW, dh), k_w.dtype)
    kw_p = jnp.concatenate([pad, k_w], axis=2)
    vw_p = jnp.concatenate([pad, v_w], axis=2)

    tab_g = rel_bias.reshape(REL_BUCKETS, G, hg).transpose(1, 0, 2)
    g_ar = jnp.arange(G)[None, :, None, None]

    def head_bias(dist):
        return jnp.moveaxis(rel_bias[t5_bucket(dist)], -1, 0).reshape(G, hg, *dist.shape)

    def block_fn(qi):
        t0 = qi * NSA_QBLOCK
        tq = t0 + jnp.arange(NSA_QBLOCK)
        qb = lax.dynamic_slice_in_dim(q, t0, NSA_QBLOCK, axis=3)

        dist_c = tq[:, None] - cmp_end[None, :]
        s = jnp.einsum('bghqd,bgnd->bghqn', qb, kc) * scale + head_bias(jnp.maximum(dist_c, 0))
        p_c = masked_softmax(s, dist_c >= 0)
        o_cmp = jnp.einsum('bghqn,bgnd->bghqd', p_c.astype(vc.dtype), vc)

        imp = jnp.einsum('bghqn,ns->bgqs', p_c, overlap)
        cur = tq // SEL_BLOCK
        forced = (sidx[None] == 0) | (sidx[None] == cur[:, None]) | (sidx[None] == cur[:, None] - 1)
        future = sidx[None] * SEL_BLOCK > tq[:, None]
        imp = jnp.where(future, -1.0, imp + jnp.where(forced, FORCE_BONUS, 0.0))
        _, idx = lax.top_k(imp, k_top)
        kg = gather_blocks(ks_blk, idx).reshape(bsz, G, NSA_QBLOCK, k_top * SEL_BLOCK, dh)
        vg = gather_blocks(vs_blk, idx).reshape(bsz, G, NSA_QBLOCK, k_top * SEL_BLOCK, dh)
        kpos = (idx[..., None] * SEL_BLOCK + jnp.arange(SEL_BLOCK)).reshape(bsz, G, NSA_QBLOCK, -1)
        dsel = tq[None, None, :, None] - kpos
        bias_sel = jnp.moveaxis(tab_g[g_ar, t5_bucket(jnp.maximum(dsel, 0))], -1, 2)
        s = jnp.einsum('bghqd,bgqkd->bghqk', qb, kg) * scale + bias_sel
        p_s = masked_softmax(s, (dsel >= 0)[:, :, None])
        o_sel = jnp.einsum('bghqk,bgqkd->bghqd', p_s.astype(vg.dtype), vg)

        kw = lax.dynamic_slice_in_dim(kw_p, t0, WINDOW + NSA_QBLOCK, axis=2)
        vw = lax.dynamic_slice_in_dim(vw_p, t0, WINDOW + NSA_QBLOCK, axis=2)
        kpos_w = t0 - WINDOW + jnp.arange(WINDOW + NSA_QBLOCK)
        dw = tq[:, None] - kpos_w[None]
        mask_w = (dw >= 0) & (dw < WINDOW) & (kpos_w[None] >= 0)
        s = jnp.einsum('bghqd,bgkd->bghqk', qb, kw) * scale + head_bias(jnp.maximum(dw, 0))
        p_w = masked_softmax(s, mask_w)
        o_win = jnp.einsum('bghqk,bgkd->bghqd', p_w.astype(vw.dtype), vw)

        g = lax.dynamic_slice_in_dim(gsel, t0, NSA_QBLOCK, axis=4)
        return g[0][..., None] * o_cmp + g[1][..., None] * o_sel + g[2][..., None] * o_win

    o = lax.map(block_fn, jnp.arange(s_len // NSA_QBLOCK))
    o = o.transpose(1, 0, 4, 2, 3, 5).reshape(bsz, s_len, B_WIDTH)
    return (o * jax.nn.silu(gate)) @ w_proj


def setup_inputs(seed: int = 0) -> dict:
    key = jax.random.key(seed)
    ks = jax.random.split(key, 20)

    def nrm(k, shape, s):
        return jax.random.normal(k, shape, jnp.float32) * s

    return {
        'x': nrm(ks[0], (BATCH, SEQ, D_MODEL), 1.0),
        'c': nrm(ks[1], (BATCH, D_MODEL), 1.0),
        'rel_bias': nrm(ks[2], (REL_BUCKETS, B_HEADS), 0.5),
        'norm_g': 1.0 + nrm(ks[3], (DEPTH, D_MODEL), 0.05),
        'w_ada': nrm(ks[4], (DEPTH, D_MODEL, 3 * D_MODEL), 0.5 * D_MODEL ** -0.5),
        'b_ada': nrm(ks[5], (DEPTH, 3 * D_MODEL), 0.01),
        'w_in': nrm(ks[6], (DEPTH, D_MODEL, N_IN_COLS), D_MODEL ** -0.5),
        'a_ln_g': 1.0 + nrm(ks[7], (DEPTH, A_WIDTH), 0.05),
        'a_ln_b': nrm(ks[8], (DEPTH, A_WIDTH), 0.01),
        'a_w_s': nrm(ks[9], (DEPTH, A_GROUPS, A_CHUNK, A_CHUNK), 0.5 * A_CHUNK ** -0.5),
        'a_b_s': 1.0 + nrm(ks[10], (DEPTH, A_GROUPS, A_CHUNK), 0.01),
        'b_w_cmp1': nrm(ks[11], (DEPTH, 2, CMP_BLOCK, B_HEAD_DIM, B_HEAD_DIM), (CMP_BLOCK * B_HEAD_DIM) ** -0.5),
        'b_w_cmp2': nrm(ks[12], (DEPTH, 2, B_HEAD_DIM, B_HEAD_DIM), B_HEAD_DIM ** -0.5),
        'b_pos_cmp': nrm(ks[13], (DEPTH, 2, CMP_BLOCK, B_HEAD_DIM), 0.1),
        'c_w_grp': nrm(ks[14], (DEPTH, len(POOL_WINDOWS), C_GROUP, C_GROUP), C_GROUP ** -0.5),
        'c_scale': 1.0 + nrm(ks[15], (DEPTH, C_WIDTH), 0.05),
        'w_branch': nrm(ks[16], (DEPTH, 3, BRANCH_WIDTH, D_MODEL), BRANCH_WIDTH ** -0.5),
        'w_out': nrm(ks[17], (DEPTH, D_MODEL, D_MODEL), D_MODEL ** -0.5),
        'final_g': 1.0 + nrm(ks[18], (D_MODEL,), 0.05),
    }


def reference(x, c, rel_bias, norm_g, w_ada, b_ada, w_in, a_ln_g, a_ln_b, a_w_s, a_b_s,
              b_w_cmp1, b_w_cmp2, b_pos_cmp, c_w_grp, c_scale, w_branch, w_out, final_g):
    for l in range(DEPTH):
        mod = jax.nn.silu(c) @ w_ada[l] + b_ada[l]
        shift, scl, gate = jnp.split(mod, 3, axis=-1)
        h = rmsnorm(x, norm_g[l]) * (1.0 + scl[:, None, :]) + shift[:, None, :]
        z = h @ w_in[l]
        (a_u, a_v, a_gate, b_q, b_kv, b_gsel, b_gate,
         c_x, c_gate, merge) = jnp.split(z, IN_SPLITS, axis=-1)
        y_a = chunked_sgu(a_u, a_v, a_gate, a_ln_g[l], a_ln_b[l], a_w_s[l], a_b_s[l], w_branch[l, 0])
        y_b = native_sparse_attention(b_q, b_kv, b_gsel, b_gate, b_w_cmp1[l], b_w_cmp2[l],
                                      b_pos_cmp[l], rel_bias, w_branch[l, 1])
        y_c = multiscale_pool(c_x, c_gate, c_w_grp[l], c_scale[l], w_branch[l, 2])
        m_a, m_b, m_c = jnp.split(jax.nn.sigmoid(merge), 3, axis=-1)
        y = m_a * y_a + m_b * y_b + m_c * y_c
        x = x + gate[:, None, :] * (y @ w_out[l])
    return rmsnorm(x, final_g)
```

```cpp
#include <hip/hip_runtime.h>
#include <hip/hip_cooperative_groups.h>
#include <cstdio>
#include <cstdint>
namespace cg = cooperative_groups;

#ifndef EN_A
#define EN_A 1
#endif
#ifndef EN_B
#define EN_B 1
#endif
#ifndef EN_C
#define EN_C 1
#endif

#define LAS __attribute__((address_space(3)))
typedef unsigned short bf16_t;
typedef short bf16x8 __attribute__((ext_vector_type(8)));
typedef float f32x4 __attribute__((ext_vector_type(4)));
typedef float f32x16 __attribute__((ext_vector_type(16)));
typedef unsigned u32x4 __attribute__((ext_vector_type(4)));
typedef unsigned u32x2 __attribute__((ext_vector_type(2)));

constexpr int D = 2048, SEQ = 2048, NB = 8, NTOK = NB * SEQ;
constexpr int NCOLS = 23600;
constexpr int NPAD = 23808;
constexpr int LDS_BYTES = 136 * 1024;
constexpr float LOG2E = 1.4426950408889634f;

constexpr size_t SZ_ACT = (size_t)NTOK * 2048 * 2;
constexpr size_t WS_WINT = 0;
constexpr size_t WS_WCXN = WS_WINT + (size_t)2 * NPAD * 2048 * 2;
constexpr size_t WS_WBRT = WS_WCXN + (size_t)2 * 2048 * 2048 * 2;
constexpr size_t WS_WOUTT = WS_WBRT + (size_t)6 * 2048 * 2048 * 2;
constexpr size_t WS_WGRPT = WS_WOUTT + (size_t)2 * 2048 * 2048 * 2;
constexpr size_t WS_WSM = WS_WGRPT + (size_t)8 * 512 * 512 * 2;
constexpr size_t WS_W1T = WS_WSM + (size_t)16 * 128 * 128 * 2;
constexpr size_t WS_W2T = WS_W1T + (size_t)4 * 256 * 2048 * 2;
constexpr size_t WS_BIAS1 = WS_W2T + (size_t)4 * 128 * 128 * 2;
constexpr size_t WS_MOD = WS_BIAS1 + 4096;
constexpr size_t WS_STATS = WS_MOD + (size_t)2 * 8 * 6144 * 4;
constexpr size_t WS_GS = WS_STATS + (size_t)2 * NTOK * 2 * 4;
constexpr size_t WS_PQ = WS_GS + (size_t)NTOK * 48 * 4;
constexpr size_t WS_H = WS_PQ + (size_t)2 * 4096 * 256 * 4 + 65536;
constexpr size_t WS_U = WS_H + SZ_ACT;
constexpr size_t WS_V = WS_U + SZ_ACT;
constexpr size_t WS_SG = WS_V + SZ_ACT;
constexpr size_t WS_Q = WS_SG + SZ_ACT;
constexpr size_t WS_SGB = WS_Q + SZ_ACT;
constexpr size_t WS_XW = WS_SGB + SZ_ACT;
constexpr size_t WS_SGC = WS_XW + SZ_ACT;
constexpr size_t WS_KV = WS_SGC + SZ_ACT;
constexpr size_t KV_SLAB = (size_t)NTOK * 512;
constexpr size_t WS_MG = WS_KV + 6 * KV_SLAB * 2 + (1 << 20);
constexpr size_t WS_XRES = WS_MG + (size_t)NTOK * 6144 * 2;
constexpr size_t WS_STATP = WS_XRES + (size_t)NTOK * 2048 * 4;
constexpr size_t WS_B1P = WS_STATP + (size_t)32 * NTOK * 2 * 4;
constexpr size_t WS_BAR = WS_B1P + 16384;
constexpr size_t WS_KCI = WS_BAR + 16384;
constexpr size_t WS_END = WS_KCI + (size_t)64 * 32768;

struct Params {
    const float* in[19];
    float* out;
    unsigned char* ws;
};
typedef const __attribute__((address_space(4))) Params* KP;
enum { I_X = 0, I_C, I_RELB, I_NORMG, I_WADA, I_BADA, I_WIN, I_ALNG, I_ALNB, I_AWS, I_ABS, I_WCMP1, I_WCMP2, I_POSCMP, I_CWGRP, I_CSCALE, I_WBR, I_WOUT, I_FINALG };

typedef float f32x2_t __attribute__((ext_vector_type(2)));
typedef __bf16 bf16x2_t __attribute__((ext_vector_type(2)));
__device__ __forceinline__ unsigned cvt_pk_bf16(float lo, float hi) { const f32x2_t v = {lo, hi}; return __builtin_bit_cast(unsigned, __builtin_convertvector(v, bf16x2_t)); }
__device__ __forceinline__ float bf_lo(unsigned w) { return __uint_as_float(w << 16); }
__device__ __forceinline__ float bf_hi(unsigned w) { return __uint_as_float(w & 0xffff0000u); }
__device__ __forceinline__ float sigmoid_f(float x) { return __builtin_amdgcn_rcpf(1.f + __expf(-x)); }
__device__ __forceinline__ float silu_f(float x) { return x * sigmoid_f(x); }
__device__ __forceinline__ float gelu_f(float x) { const float u = 1.5957691216057308f * (x + 0.044715f * x * x * x); return x * sigmoid_f(u); }
__device__ __forceinline__ float shfl_xor_l(float v, int o, int lane) { return __builtin_bit_cast(float, __builtin_amdgcn_ds_bpermute(((lane ^ o) & 63) << 2, __builtin_bit_cast(int, v))); }
__device__ __forceinline__ float wave_sum(float v, int lane) {
#pragma unroll
    for (int o = 1; o < 64; o <<= 1) v += shfl_xor_l(v, o, lane);
    return v;
}
template <class T> __device__ __forceinline__ T* launder(T* p) { size_t z = 0; asm volatile("" : "+s"(z)); return (T*)((unsigned char*)p + z); }
extern __shared__ __attribute__((aligned(16))) unsigned char lds_raw[];
constexpr int TID_TAB_OFF = 135424;
__device__ __forceinline__ int hw_slot() { return (int)(__builtin_amdgcn_s_getreg((5 << 11) | 4) & 63u); }
__device__ __forceinline__ int opaque_tid() {
    unsigned z = 0u; asm volatile("" : "+v"(z));
    const int lane = (int)__builtin_amdgcn_mbcnt_hi(~0u, __builtin_amdgcn_mbcnt_lo(~0u, z));
    const int w = *(volatile LAS int*)((LAS unsigned char*)lds_raw + TID_TAB_OFF + hw_slot() * 4);
    int t = (w << 6) | lane; asm volatile("" : "+v"(t)); return t;
}
#define WAIT_VM0() asm volatile("s_waitcnt vmcnt(0)" ::: "memory")
#define WAIT_LGKM0() asm volatile("s_waitcnt lgkmcnt(0)" ::: "memory")
__device__ __forceinline__ void block_sync() { asm volatile("s_waitcnt vmcnt(0) lgkmcnt(0)" ::: "memory"); __builtin_amdgcn_s_barrier(); asm volatile("" ::: "memory"); }

namespace pg8 {
constexpr int BM = 256, BK = 64, HALF = 128, HTB = HALF * BK * 2, NXCD = 8, WGM = 8;
__device__ __forceinline__ int lds_byte(int r, int c) { const int st = (r >> 4) * 2 + (c >> 5), rr = r & 15, cc = c & 31, ob = rr * 64 + cc * 2; return st * 1024 + (ob ^ (((ob >> 9) & 1) << 5)); }
__device__ __forceinline__ void stage_rc(int b, int& R, int& C) { const int st = b / 1024, sb = b % 1024, swz = sb ^ (((sb >> 9) & 1) << 5); R = (st >> 1) * 16 + swz / 64; C = (st & 1) * 32 + (swz % 64) / 2; }
__device__ __forceinline__ int perm32(int rho) { const int n = rho >> 4, i = rho & 15; return 8 * (i >> 2) + 4 * n + (i & 3); }
struct Unit { int pm, pn, z; };
__device__ __forceinline__ void tile_swizzle(int wgid, int nM, int nN, int& pm, int& pn) {
    const int nwg = nM * nN;
    { const int q = nwg / NXCD, r = nwg % NXCD, xcd = wgid % NXCD, off = wgid / NXCD; wgid = (xcd < r ? xcd * (q + 1) : r * (q + 1) + (xcd - r) * q) + off; }
    const int nig = WGM * nN, gid = wgid / nig, fm = gid * WGM, gsz = (nM - fm) < WGM ? (nM - fm) : WGM;
    pm = fm + ((wgid % nig) % gsz); pn = (wgid % nig) / gsz;
}
template <class Sched, class Epi>
__device__ __forceinline__ void gemm_phase(LAS unsigned char* lds, const int K, const int lda, const int ldb, const Sched& S, const Epi& E) {
    const int tid = opaque_tid(), wid = __builtin_amdgcn_readfirstlane(tid >> 6), lane = tid & 63, wr = wid >> 2, wc = wid & 3, fr = lane & 15, fq = lane >> 4;
    const int nt = K / BK;
    unsigned voffA[2], voffB[2];
#pragma unroll
    for (int i = 0; i < 2; ++i) { int R, C; stage_rc(tid * 16 + i * 8192, R, C); const int Rb = (R & ~31) + perm32(R & 31);
        voffA[i] = (unsigned)(R * lda + C) * 2u; voffB[i] = (unsigned)(Rb * ldb + C) * 2u; }
    const size_t kstep = (size_t)(BK * 2);
    const size_t hstepA = (size_t)HALF * lda * 2, hstepB = (size_t)HALF * ldb * 2;
    const unsigned ldsw = (unsigned)wid * 1024u;
    const int aoff = lds_byte(wr * 64 + fr, fq * 8), boff = lds_byte(wc * 32 + fr, fq * 8);
#define PG8_SA(b, h) (((b) * 2 + (h)) * HTB)
#define PG8_SB(b, h) ((4 + (b) * 2 + (h)) * HTB)
#define PG8_STAGE(bufoff, gbase, voff) do { _Pragma("unroll") for (int _i = 0; _i < 2; ++_i) \
        __builtin_amdgcn_global_load_lds((const unsigned*)((const char*)(gbase) + (voff)[_i]), (LAS unsigned*)(lds + (bufoff) + ldsw + _i * 8192), 16, 0, 0); } while (0)
#define PG8_LDA(dst, b, h) do { _Pragma("unroll") for (int m = 0; m < 4; ++m) _Pragma("unroll") for (int k = 0; k < 2; ++k) dst[m][k] = *(const LAS bf16x8*)(lds + PG8_SA(b, h) + aoff + m * 2048 + k * 1024); } while (0)
#define PG8_LDB(dst, b, h) do { _Pragma("unroll") for (int n = 0; n < 2; ++n) _Pragma("unroll") for (int k = 0; k < 2; ++k) dst[n][k] = *(const LAS bf16x8*)(lds + PG8_SB(b, h) + boff + n * 2048 + k * 1024); } while (0)
#define PG8_MMA(ai, bj, At, Bt) do { __builtin_amdgcn_s_setprio(1); _Pragma("unroll") for (int m = 0; m < 4; ++m) _Pragma("unroll") for (int n = 0; n < 2; ++n) _Pragma("unroll") for (int k = 0; k < 2; ++k) \
        acc[ai][bj][m][n] = __builtin_amdgcn_mfma_f32_16x16x32_bf16(Bt[n][k], At[m][k], acc[ai][bj][m][n], 0, 0, 0); __builtin_amdgcn_s_setprio(0); } while (0)
#define PG8_WAIT_V(n) asm volatile("s_waitcnt vmcnt(" #n ")" ::: "memory")
#define PG8_WAIT_L(n) asm volatile("s_waitcnt lgkmcnt(" #n ")" ::: "memory")
#define PG8_BAR __builtin_amdgcn_s_barrier()
#define PG8_SCHED __builtin_amdgcn_sched_barrier(0)
    Unit cur, nxt; int ui = 0;
    if (!S.next(0, cur)) return;
    f32x4 acc[2][2][4][2];
#pragma unroll
    for (int a = 0; a < 2; ++a)
#pragma unroll
        for (int b = 0; b < 2; ++b)
#pragma unroll
            for (int m = 0; m < 4; ++m)
#pragma unroll
                for (int n = 0; n < 2; ++n) acc[a][b][m][n] = (f32x4){0.f, 0.f, 0.f, 0.f};
    bf16x8 At[4][2], B0[2][2], B1[2][2];
    const char* cA = launder(S.abase(cur)); const char* cB = launder(S.bbase(cur));
    PG8_STAGE(PG8_SB(0, 0), cB, voffB); PG8_STAGE(PG8_SA(0, 0), cA, voffA); PG8_STAGE(PG8_SB(0, 1), cB + hstepB, voffB); PG8_STAGE(PG8_SA(0, 1), cA + hstepA, voffA);
    if (wr == 1) PG8_BAR;
    PG8_WAIT_V(4); PG8_BAR;
    PG8_STAGE(PG8_SB(1, 0), cB + kstep, voffB); PG8_STAGE(PG8_SA(1, 0), cA + kstep, voffA); PG8_STAGE(PG8_SB(1, 1), cB + hstepB + kstep, voffB);
    PG8_WAIT_V(6); PG8_BAR;
    for (;;) {
        const bool has_next = S.next(ui + 1, nxt);
        const char* nA = has_next ? launder(S.abase(nxt)) : cA; const char* nB = has_next ? launder(S.bbase(nxt)) : cB;
        for (int t = 0; t < nt; t += 2) {
            const bool last = (t == nt - 2);
            const char* a1 = cA + (size_t)(t + 1) * kstep;
            const char* a2 = last ? nA : cA + (size_t)(t + 2) * kstep; const char* b2 = last ? nB : cB + (size_t)(t + 2) * kstep;
            const char* a3 = a2 + kstep; const char* b3 = b2 + kstep;
            PG8_LDB(B0, 0, 0); PG8_SCHED; PG8_LDA(At, 0, 0); PG8_STAGE(PG8_SA(1, 1), a1 + hstepA, voffA);
            PG8_WAIT_L(8); PG8_BAR; PG8_WAIT_L(0); PG8_MMA(0, 0, At, B0); PG8_BAR; PG8_SCHED;
            PG8_LDB(B1, 0, 1); PG8_STAGE(PG8_SB(0, 0), b2, voffB);
            PG8_BAR; PG8_WAIT_L(0); PG8_MMA(0, 1, At, B1); PG8_BAR;
            PG8_LDA(At, 0, 1); PG8_STAGE(PG8_SA(0, 0), a2, voffA);
            PG8_BAR; PG8_WAIT_L(0); PG8_MMA(1, 0, At, B0); PG8_BAR; PG8_SCHED;
            PG8_STAGE(PG8_SB(0, 1), b2 + hstepB, voffB);
            PG8_WAIT_V(6); PG8_BAR; PG8_MMA(1, 1, At, B1); PG8_BAR;
            PG8_LDB(B0, 1, 0); PG8_SCHED; PG8_LDA(At, 1, 0); PG8_STAGE(PG8_SA(0, 1), a2 + hstepA, voffA);
            PG8_WAIT_L(8); PG8_BAR; PG8_WAIT_L(0); PG8_MMA(0, 0, At, B0); PG8_BAR; PG8_SCHED;
            PG8_LDB(B1, 1, 1); PG8_STAGE(PG8_SB(1, 0), b3, voffB);
            PG8_BAR; PG8_WAIT_L(0); PG8_MMA(0, 1, At, B1); PG8_BAR;
            PG8_LDA(At, 1, 1); PG8_STAGE(PG8_SA(1, 0), a3, voffA);
            PG8_BAR; PG8_WAIT_L(0); PG8_MMA(1, 0, At, B0); PG8_BAR; PG8_SCHED;
            PG8_STAGE(PG8_SB(1, 1), b3 + hstepB, voffB);
            PG8_WAIT_V(6); PG8_BAR; PG8_MMA(1, 1, At, B1); PG8_BAR;
        }
        E(acc, cur, wr, wc, fr, fq);
        if (!has_next) break;
#pragma unroll
        for (int a = 0; a < 2; ++a)
#pragma unroll
            for (int b = 0; b < 2; ++b)
#pragma unroll
                for (int m = 0; m < 4; ++m)
#pragma unroll
                    for (int n = 0; n < 2; ++n) acc[a][b][m][n] = (f32x4){0.f, 0.f, 0.f, 0.f};
        cur = nxt; cA = nA; cB = nB; ++ui;
    }
    PG8_WAIT_V(0);
    if (wr == 0) PG8_BAR;
    PG8_BAR;
#undef PG8_SA
#undef PG8_SB
#undef PG8_STAGE
#undef PG8_LDA
#undef PG8_LDB
#undef PG8_MMA
#undef PG8_WAIT_V
#undef PG8_WAIT_L
#undef PG8_BAR
#undef PG8_SCHED
}
}
using pg8::Unit;
typedef f32x4 AccT[2][2][4][2];

struct SchedStd {
    const char* A; const char* B; int lda, ldb, nM, nN, nZ; size_t zA, zB; int G, c;
    __device__ __forceinline__ bool next(int i, Unit& u) const {
        const long L = (long)i * G + c; const int per = nM * nN; if (L >= (long)per * nZ) return false;
        u.z = (int)(L / per); pg8::tile_swizzle((int)(L % per), nM, nN, u.pm, u.pn); return true; }
    __device__ __forceinline__ const char* abase(const Unit& u) const { return A + (size_t)u.z * zA + (size_t)u.pm * 256 * lda * 2; }
    __device__ __forceinline__ const char* bbase(const Unit& u) const { return B + (size_t)u.z * zB + (size_t)u.pn * 256 * ldb * 2; }
};
struct SchedFold {
    const char* A; const char* B; int G, c;
    __device__ __forceinline__ bool next(int i, Unit& u) const {
        const int L = i * G + c; if (L >= 128) return false; u.z = L >> 4; u.pm = (L >> 3) & 1; u.pn = L & 7; return true; }
    __device__ __forceinline__ const char* abase(const Unit& u) const { return A + (size_t)u.z * 512 * 512 * 2 + (size_t)u.pm * 256 * 512 * 2; }
    __device__ __forceinline__ const char* bbase(const Unit& u) const { return B + (size_t)(u.z >> 2) * 2048 * 2048 * 2 + (size_t)(u.z & 3) * 512 * 2 + (size_t)u.pn * 256 * 2048 * 2; }
};
struct SchedBranch {
    const char* A0; const char* A1; const char* A2; const char* B; int G, c;
    __device__ __forceinline__ bool next(int i, Unit& u) const {
        const int L = (i / 3) * G + c; if (L >= 512) return false; u.z = i % 3; pg8::tile_swizzle(L, 64, 8, u.pm, u.pn); return true; }
    __device__ __forceinline__ const char* abase(const Unit& u) const { const char* a = u.z == 0 ? A0 : (u.z == 1 ? A1 : A2); return a + (size_t)u.pm * 256 * 2048 * 2; }
    __device__ __forceinline__ const char* bbase(const Unit& u) const { return B + (size_t)u.z * 2048 * 2048 * 2 + (size_t)u.pn * 256 * 2048 * 2; }
};

struct SchedL3a {
    const char* KC; const char* W1; const char* H; const char* WG; int G, c;
    __device__ __forceinline__ bool next(int i, Unit& u) const {
        const int L = i * G + c; if (L >= 96) return false;
        if (L < 32) { u.z = L >> 4; u.pm = L & 15; u.pn = 0; } else { u.z = 2; u.pm = L - 32; u.pn = 0; }
        return true; }
    __device__ __forceinline__ const char* abase(const Unit& u) const { return (u.z == 2 ? H : KC + (size_t)u.z * 4096 * 2048 * 2) + (size_t)u.pm * 256 * 2048 * 2; }
    __device__ __forceinline__ const char* bbase(const Unit& u) const { return u.z == 2 ? WG : W1 + (size_t)u.z * 256 * 2048 * 2; }
};

#define EPI_ROW(ai, m) (u.pm * 256 + (ai) * 128 + wr * 64 + (m) * 16 + fr)
#define EPI_COLT(bj) ((bj) * 128 + wc * 32 + 8 * fq)
__device__ __forceinline__ u32x4 pack8(const f32x4 a, const f32x4 b) { u32x4 w; w.x = cvt_pk_bf16(a[0], a[1]); w.y = cvt_pk_bf16(a[2], a[3]); w.z = cvt_pk_bf16(b[0], b[1]); w.w = cvt_pk_bf16(b[2], b[3]); return w; }

struct EpiMain {
    unsigned char* ws0; int layer;
    __device__ __forceinline__ void operator()(const AccT& acc, const Unit& u, int wr, int wc, int fr, int fq) const {
        unsigned char* ws = launder(this->ws0);
        const int pn = u.pn;
        int act, store = 0, cb = 0, ldc = 2048; bf16_t* dst = nullptr; bool stats = false;
        if (pn < 8) { act = 0; dst = (bf16_t*)(ws + WS_U); cb = pn * 256; }
        else if (pn < 16) { act = 1; dst = (bf16_t*)(ws + WS_V); cb = (pn - 8) * 256; stats = true; }
        else if (pn < 24) { act = 0; dst = (bf16_t*)(ws + WS_SG); cb = (pn - 16) * 256; }
        else if (pn < 32) { act = 4; dst = (bf16_t*)(ws + WS_Q); cb = (pn - 24) * 256; }
        else if (pn < 44) { act = 0; const int j = (pn - 32) >> 1; store = (j < 2) ? 1 : ((j & 1) ? 2 : 4); dst = (bf16_t*)(ws + WS_KV) + (size_t)j * KV_SLAB; cb = ((pn - 32) & 1) * 2; }
        else if (pn < 52) { act = 0; dst = (bf16_t*)(ws + WS_SGB); cb = (pn - 44) * 256; }
        else if (pn < 60) { act = 0; dst = (bf16_t*)(ws + WS_XW); cb = (pn - 52) * 256; }
        else if (pn < 68) { act = 0; dst = (bf16_t*)(ws + WS_SGC); cb = (pn - 60) * 256; }
        else { act = 3; dst = (bf16_t*)(ws + WS_MG); cb = (pn - 68) * 256; ldc = 6144; }
        float* st = (float*)(ws + WS_STATP) + (size_t)(((pn - 8) & 7) * 4 + wc) * NTOK * 2;
#pragma unroll
        for (int ai = 0; ai < 2; ++ai)
#pragma unroll
            for (int m = 0; m < 4; ++m) {
                const int row = EPI_ROW(ai, m);
                float rs = 0.f, rq = 0.f;
#pragma unroll
                for (int bj = 0; bj < 2; ++bj) {
                    f32x4 v0 = acc[ai][bj][m][0], v1 = acc[ai][bj][m][1];
                    if (act == 1) {
#pragma unroll
                        for (int j = 0; j < 4; ++j) { v0[j] = gelu_f(v0[j]); v1[j] = gelu_f(v1[j]); }
                    } else if (act == 2) {
#pragma unroll
                        for (int j = 0; j < 4; ++j) { v0[j] = silu_f(v0[j]); v1[j] = silu_f(v1[j]); }
                    } else if (act == 3) {
#pragma unroll
                        for (int j = 0; j < 4; ++j) { v0[j] = sigmoid_f(v0[j]); v1[j] = sigmoid_f(v1[j]); }
                    } else if (act == 4) {
                        const float qs = 0.08838834764831845f * LOG2E;
                        v0 = v0 * qs; v1 = v1 * qs;
                    }
                    if (stats) {
#pragma unroll
                        for (int j = 0; j < 4; ++j) { rs += v0[j] + v1[j]; rq += v0[j] * v0[j] + v1[j] * v1[j]; }
                    }
                    const int colt = EPI_COLT(bj);
                    if (store == 0) {
                        __builtin_nontemporal_store(pack8(v0, v1), (u32x4*)(dst + (size_t)row * ldc + cb + colt));
                    } else if (store == 1) {
                        const int bb = row >> 11, t = row & 2047, g = cb + bj, d0 = wc * 32 + 8 * fq;
                        *(u32x4*)(dst + ((size_t)(bb * 4 + g) * 2048 + t) * 128 + d0) = pack8(v0, v1);
                    } else if (store == 4) {
                        const int bb = row >> 11, t = row & 2047, g = cb + bj, c = wc * 4 + fq;
                        *(u32x4*)(dst + ((((size_t)(bb * 4 + g) * 32 + (t >> 6)) * 16 + c) * 64 + (t & 63)) * 8) = pack8(v0, v1);
                    } else if (store == 2) {
                        const int bb = row >> 11, t = row & 2047, g = cb + bj, d0 = wc * 32 + 8 * fq;
                        bf16_t* pp = dst + ((((size_t)(bb * 4 + g) * 32 + (t >> 6)) * 8 + ((t & 63) >> 3)) * 128 + d0) * 8 + (t & 7);
                        const u32x4 w = pack8(v0, v1);
                        pp[0] = (bf16_t)(w.x & 0xffff); pp[8] = (bf16_t)(w.x >> 16); pp[16] = (bf16_t)(w.y & 0xffff); pp[24] = (bf16_t)(w.y >> 16);
                        pp[32] = (bf16_t)(w.z & 0xffff); pp[40] = (bf16_t)(w.z >> 16); pp[48] = (bf16_t)(w.w & 0xffff); pp[56] = (bf16_t)(w.w >> 16);
                    }
                }
                if (stats) {
                    { const int ln = fq * 16 + fr; rs += shfl_xor_l(rs, 16, ln); rs += shfl_xor_l(rs, 32, ln); rq += shfl_xor_l(rq, 16, ln); rq += shfl_xor_l(rq, 32, ln); }
                    if (fq == 0) { typedef float f32x2 __attribute__((ext_vector_type(2))); *(f32x2*)(st + (size_t)row * 2) = (f32x2){rs, rq}; }
                }
            }
    }
};
struct EpiFold {
    unsigned char* ws0;
    __device__ __forceinline__ void operator()(const AccT& acc, const Unit& u, int wr, int wc, int fr, int fq) const {
        unsigned char* ws = launder(ws0);
        const int l = u.z >> 2, gi = u.z & 3;
        bf16_t* dst = (bf16_t*)(ws + WS_WINT) + ((size_t)l * NPAD + 13312 + gi * 512) * 2048;
#pragma unroll
        for (int ai = 0; ai < 2; ++ai)
#pragma unroll
            for (int m = 0; m < 4; ++m)
#pragma unroll
                for (int bj = 0; bj < 2; ++bj)
                    *(u32x4*)(dst + (size_t)EPI_ROW(ai, m) * 2048 + u.pn * 256 + EPI_COLT(bj)) = pack8(acc[ai][bj][m][0], acc[ai][bj][m][1]);
    }
};
struct EpiCmp {
    unsigned char* ws0;
    __device__ __forceinline__ void operator()(const AccT& acc, const Unit& u, int wr, int wc, int fr, int fq) const {
        unsigned char* ws = launder(ws0);
        if (u.z < 2) {
            float* dst = (float*)(ws + WS_PQ) + (size_t)u.z * 4096 * 256;
#pragma unroll
            for (int ai = 0; ai < 2; ++ai)
#pragma unroll
                for (int m = 0; m < 4; ++m)
#pragma unroll
                    for (int bj = 0; bj < 2; ++bj) { float* pp = dst + (size_t)EPI_ROW(ai, m) * 256 + EPI_COLT(bj); *(f32x4*)pp = acc[ai][bj][m][0]; *(f32x4*)(pp + 4) = acc[ai][bj][m][1]; }
        } else {
            float* gs = (float*)(ws + WS_GS);
            const int colt = EPI_COLT(0);
            if (colt < 48) {
#pragma unroll
                for (int ai = 0; ai < 2; ++ai)
#pragma unroll
                    for (int m = 0; m < 4; ++m) { f32x4 v0 = acc[ai][0][m][0], v1 = acc[ai][0][m][1];
#pragma unroll
                        for (int j = 0; j < 4; ++j) { v0[j] = sigmoid_f(v0[j]); v1[j] = sigmoid_f(v1[j]); }
                        float* pp = gs + (size_t)EPI_ROW(ai, m) * 48 + colt; *(f32x4*)pp = v0; *(f32x4*)(pp + 4) = v1; }
            }
        }
    }
};
struct EpiBranch {
    unsigned char* ws0;
    __device__ __forceinline__ void operator()(const AccT& acc, const Unit& u, int wr, int wc, int fr, int fq) const {
        unsigned char* ws = launder(ws0);
        float* tmp = (float*)(ws + WS_H) + (size_t)blockIdx.x * 65536;
        const bf16_t* mg = (const bf16_t*)(ws + WS_MG);
        bf16_t* y = (bf16_t*)(ws + WS_V);
        const int x = u.z;
        if (x > 0) __builtin_amdgcn_fence(__ATOMIC_ACQUIRE, "agent");
#pragma unroll
        for (int ai = 0; ai < 2; ++ai)
#pragma unroll
            for (int mh = 0; mh < 2; ++mh) {
                u32x4 mw[2][2]; f32x4 t0[2][2], t1[2][2];
#pragma unroll
                for (int mm = 0; mm < 2; ++mm)
#pragma unroll
                    for (int bj = 0; bj < 2; ++bj) {
                        const int m = 2 * mh + mm, row = EPI_ROW(ai, m), rl = ai * 128 + wr * 64 + m * 16 + fr, colt = EPI_COLT(bj);
                        mw[mm][bj] = *(const u32x4*)(mg + (size_t)row * 6144 + x * 2048 + u.pn * 256 + colt);
                        if (x > 0) { const float* tp = tmp + rl * 256 + colt; t0[mm][bj] = *(const f32x4*)tp; t1[mm][bj] = *(const f32x4*)(tp + 4); }
                    }
#pragma unroll
                for (int mm = 0; mm < 2; ++mm)
#pragma unroll
                    for (int bj = 0; bj < 2; ++bj) {
                        const int m = 2 * mh + mm, row = EPI_ROW(ai, m), rl = ai * 128 + wr * 64 + m * 16 + fr, colt = EPI_COLT(bj);
                        const u32x4 w = mw[mm][bj];
                        f32x4 v0 = acc[ai][bj][m][0], v1 = acc[ai][bj][m][1];
                        v0[0] *= bf_lo(w.x); v0[1] *= bf_hi(w.x); v0[2] *= bf_lo(w.y); v0[3] *= bf_hi(w.y);
                        v1[0] *= bf_lo(w.z); v1[1] *= bf_hi(w.z); v1[2] *= bf_lo(w.w); v1[3] *= bf_hi(w.w);
                        if ((!EN_A && x == 0) || (!EN_B && x == 1) || (!EN_C && x == 2)) { v0 = v0 * 0.f; v1 = v1 * 0.f; }
                        float* tp = tmp + rl * 256 + colt;
                        if (x > 0) { v0 = v0 + t0[mm][bj]; v1 = v1 + t1[mm][bj]; }
                        if (x < 2) { *(f32x4*)tp = v0; *(f32x4*)(tp + 4) = v1; }
                        else *(u32x4*)(y + (size_t)row * 2048 + u.pn * 256 + colt) = pack8(v0, v1);
                    }
            }
    }
};
struct EpiOut {
    const float* xin0; float* xout0; const float* gate0;
    __device__ __forceinline__ void operator()(const AccT& acc, const Unit& u, int wr, int wc, int fr, int fq) const {
        const float* xin = launder(xin0); float* xout = launder(xout0); const float* gate = launder(gate0);
        const int bb = (u.pm * 256) >> 11;
        f32x4 g0[2], g1[2];
#pragma unroll
        for (int bj = 0; bj < 2; ++bj) { const int col = u.pn * 256 + EPI_COLT(bj); g0[bj] = *(const f32x4*)(gate + (size_t)bb * 6144 + col); g1[bj] = *(const f32x4*)(gate + (size_t)bb * 6144 + col + 4); }
#pragma unroll
        for (int ai = 0; ai < 2; ++ai)
            {
                constexpr int mh = 0;
                f32x4 x0[4][2], x1[4][2];
#pragma unroll
                for (int mm = 0; mm < 4; ++mm)
#pragma unroll
                    for (int bj = 0; bj < 2; ++bj) { const int row = EPI_ROW(ai, 2 * mh + mm), col = u.pn * 256 + EPI_COLT(bj);
                        x0[mm][bj] = *(const f32x4*)(xin + (size_t)row * 2048 + col); x1[mm][bj] = *(const f32x4*)(xin + (size_t)row * 2048 + col + 4); }
#pragma unroll
                for (int mm = 0; mm < 4; ++mm)
#pragma unroll
                    for (int bj = 0; bj < 2; ++bj) { const int m = 2 * mh + mm, row = EPI_ROW(ai, m), col = u.pn * 256 + EPI_COLT(bj);
                        *(f32x4*)(xout + (size_t)row * 2048 + col) = x0[mm][bj] + g0[bj] * acc[ai][bj][m][0];
                        *(f32x4*)(xout + (size_t)row * 2048 + col + 4) = x1[mm][bj] + g1[bj] * acc[ai][bj][m][1]; }
            }
    }
};

__device__ __forceinline__ void wave_transpose(const float* src, int lds_, int nvalid, bf16_t* dst, int ldd, int lane, LAS unsigned char* wl) {
    const bool ok = lane < nvalid;
    const float* s = src + lane;
#pragma unroll
    for (int half = 0; half < 2; ++half) {
        float v[32];
#pragma unroll
        for (int j = 0; j < 32; ++j) v[j] = ok ? s[(size_t)(half * 32 + j) * lds_] : 0.f;
#pragma unroll
        for (int c = 0; c < 4; ++c) {
            u32x4 o; o.x = cvt_pk_bf16(v[8 * c], v[8 * c + 1]); o.y = cvt_pk_bf16(v[8 * c + 2], v[8 * c + 3]); o.z = cvt_pk_bf16(v[8 * c + 4], v[8 * c + 5]); o.w = cvt_pk_bf16(v[8 * c + 6], v[8 * c + 7]);
            *(LAS u32x4*)(wl + lane * 144 + (half * 4 + c) * 16) = o;
        }
    }
    asm volatile("s_waitcnt lgkmcnt(0)" ::: "memory");
#pragma unroll
    for (int j = 0; j < 8; ++j) {
        const int n = (lane >> 3) + 8 * j, c = lane & 7;
        const u32x4 o = *(const LAS u32x4*)(wl + n * 144 + c * 16);
        *(u32x4*)(dst + (size_t)n * ldd + c * 8) = o;
    }
    asm volatile("s_waitcnt lgkmcnt(0)" ::: "memory");
}

__device__ __forceinline__ void prep_phase(const KP p, LAS unsigned char* lds) {
    unsigned char* ws = launder(p->ws);
    const int tid = opaque_tid(), lane = tid & 63;
    constexpr int N_MOD = 192, N_B1 = 32, N_WCX = 64, N_WSM = 16, NBLK = N_MOD + N_B1 + N_WCX + N_WSM;
    for (int it = blockIdx.x; it < NBLK; it += gridDim.x) {
        int r = it;
        if (r < N_MOD) {
            const int l = r / 96, c0 = (r % 96) * 64;
            LAS float* sc = (LAS float*)lds;
            LAS float* red = sc + 8 * 2048;
            for (int e = tid; e < 8 * 2048; e += 512) sc[e] = silu_f(p->in[I_C][e]);
            block_sync();
            const int c4 = (tid & 15) * 4, ks = tid >> 4;
            f32x4 a[8];
#pragma unroll
            for (int b = 0; b < 8; ++b) a[b] = (f32x4){0.f, 0.f, 0.f, 0.f};
            const float* w = p->in[I_WADA] + (size_t)l * 2048 * 6144 + c0 + c4;
#pragma unroll 8
            for (int k = ks * 64; k < ks * 64 + 64; ++k) { const f32x4 wv = *(const f32x4*)(w + (size_t)k * 6144);
#pragma unroll
                for (int b = 0; b < 8; ++b) a[b] = a[b] + wv * sc[b * 2048 + k]; }
#pragma unroll
            for (int b = 0; b < 8; ++b) *(LAS f32x4*)(red + (ks * 8 + b) * 64 + c4) = a[b];
            block_sync();
            { const int b = tid >> 6, col = tid & 63; float s = p->in[I_BADA][(size_t)l * 6144 + c0 + col];
#pragma unroll 8
              for (int k2 = 0; k2 < 32; ++k2) s += red[(k2 * 8 + b) * 64 + col];
              ((float*)(ws + WS_MOD))[((size_t)l * 8 + b) * 6144 + c0 + col] = s; }
            block_sync();
            continue;
        } r -= N_MOD;
        if (r < N_B1) {
            LAS float* red = (LAS float*)lds;
            const int mi = r >> 3, part = r & 7, e = tid & 127, ks = tid >> 7; float s = 0.f;
            const float* pos = p->in[I_POSCMP] + (size_t)mi * 4096; const float* w1 = p->in[I_WCMP1] + (size_t)mi * 4096 * 128;
#pragma unroll 16
            for (int k = part * 512 + ks * 128; k < part * 512 + ks * 128 + 128; ++k) s += pos[k] * w1[(size_t)k * 128 + e];
            red[tid] = s; block_sync();
            if (tid < 128) ((float*)(ws + WS_B1P))[r * 128 + tid] = (red[tid] + red[tid + 128]) + (red[tid + 256] + red[tid + 384]);
            block_sync();
            continue;
        } r -= N_B1;
        if (r < N_WCX) {
            const int l = r >> 5, k0 = (r & 31) * 64;
#pragma unroll 4
            for (int e = tid; e < 64 * 512; e += 512) { const int k = k0 + (e >> 9), c4 = (e & 511) * 4;
                const f32x4 v = *(const f32x4*)(p->in[I_WIN] + (size_t)l * 2048 * NCOLS + (size_t)k * NCOLS + 13360 + c4);
                u32x2 o; o.x = cvt_pk_bf16(v[0], v[1]); o.y = cvt_pk_bf16(v[2], v[3]);
                *(u32x2*)((bf16_t*)(ws + WS_WCXN) + (size_t)l * 2048 * 2048 + (size_t)k * 2048 + c4) = o; }
            continue;
        } r -= N_WCX;
        {
            const float* srcp = p->in[I_AWS] + (size_t)r * 16384; bf16_t* dst = (bf16_t*)(ws + WS_WSM) + (size_t)r * 16384;
            for (int e = tid; e < 8192; e += 512) { const int t = (2 * e) >> 7, s = (2 * e) & 127;
                const float a = s <= t ? srcp[2 * e] : 0.f, b = (s + 1) <= t ? srcp[2 * e + 1] : 0.f;
                *(unsigned*)(dst + 2 * e) = cvt_pk_bf16(a, b); }
        }
    }
    constexpr int T_WIN = 2 * 340 * 32, T_WBR = 6 * 1024, T_WOUT = 2 * 1024, T_WGRP = 8 * 64, T_W1 = 4 * 128, T_W2 = 4 * 4;
    constexpr int T_TOTAL = T_WIN + T_WBR + T_WOUT + T_WGRP + T_W1 + T_W2;
    const int gw = blockIdx.x * 8 + (tid >> 6), nw = gridDim.x * 8;
    LAS unsigned char* wl = lds + (tid >> 6) * 9216;
    for (int it0 = gw; it0 < T_TOTAL; it0 += nw) {
        int r = __builtin_amdgcn_readfirstlane(it0);
        if (r < T_WIN) {
            const int l = r / (340 * 32); r -= l * 340 * 32; const int kt = r / 340; int nt = r - kt * 340; if (nt >= 208) nt += 32;
            const int n0 = nt * 64; int srcc, nvalid = 64;
            if (n0 < 11264) srcc = n0; else if (n0 < 23552) srcc = n0 + 48; else if (n0 == 23552) { srcc = 11264; nvalid = 48; } else { srcc = 0; nvalid = 0; }
            wave_transpose(p->in[I_WIN] + (size_t)l * 2048 * NCOLS + (size_t)kt * 64 * NCOLS + srcc, NCOLS, nvalid, (bf16_t*)(ws + WS_WINT) + ((size_t)l * NPAD + n0) * 2048 + kt * 64, 2048, lane, wl);
            continue;
        } r -= T_WIN;
        if (r < T_WBR) { const int mi = r >> 10; r &= 1023; const int kt = r >> 5, nt = r & 31;
            wave_transpose(p->in[I_WBR] + (size_t)mi * 2048 * 2048 + (size_t)kt * 64 * 2048 + nt * 64, 2048, 64, (bf16_t*)(ws + WS_WBRT) + (size_t)mi * 2048 * 2048 + (size_t)nt * 64 * 2048 + kt * 64, 2048, lane, wl); continue; } r -= T_WBR;
        if (r < T_WOUT) { const int mi = r >> 10; r &= 1023; const int kt = r >> 5, nt = r & 31;
            wave_transpose(p->in[I_WOUT] + (size_t)mi * 2048 * 2048 + (size_t)kt * 64 * 2048 + nt * 64, 2048, 64, (bf16_t*)(ws + WS_WOUTT) + (size_t)mi * 2048 * 2048 + (size_t)nt * 64 * 2048 + kt * 64, 2048, lane, wl); continue; } r -= T_WOUT;
        if (r < T_WGRP) { const int mi = r >> 6; r &= 63; const int kt = r >> 3, nt = r & 7;
            wave_transpose(p->in[I_CWGRP] + (size_t)mi * 512 * 512 + (size_t)kt * 64 * 512 + nt * 64, 512, 64, (bf16_t*)(ws + WS_WGRPT) + (size_t)mi * 512 * 512 + (size_t)nt * 64 * 512 + kt * 64, 512, lane, wl); continue; } r -= T_WGRP;
        if (r < T_W1) { const int mi = r >> 7; r &= 127; const int hh = r >> 6, kt = (r >> 1) & 31, nt = r & 1;
            wave_transpose(p->in[I_WCMP1] + (size_t)mi * 4096 * 128 + (size_t)(hh * 2048 + kt * 64) * 128 + nt * 64, 128, 64, (bf16_t*)(ws + WS_W1T) + (size_t)mi * 256 * 2048 + (size_t)(hh * 128 + nt * 64) * 2048 + kt * 64, 2048, lane, wl); continue; } r -= T_W1;
        { const int mi = r >> 2, kt = (r >> 1) & 1, nt = r & 1;
            wave_transpose(p->in[I_WCMP2] + (size_t)mi * 128 * 128 + (size_t)kt * 64 * 128 + nt * 64, 128, 64, (bf16_t*)(ws + WS_W2T) + (size_t)mi * 128 * 128 + (size_t)nt * 64 * 128 + kt * 64, 128, lane, wl); }
    }
}

__device__ __forceinline__ void rms_mod_phase(const float* x0, const float* g0, const float* mod0  , bf16_t* h0) {
    const float* x = launder(x0); const float* g = launder(g0); const float* mod = launder(mod0); bf16_t* h = launder(h0);
    const int tid_ = opaque_tid(); const int lane = tid_ & 63, gw = blockIdx.x * 8 + (tid_ >> 6), nw = gridDim.x * 8;
    for (int chunk = gw; chunk < NTOK / 8; chunk += nw) {
        const int row0 = chunk * 8;
        const float* mb = mod + (size_t)(row0 >> 11) * 6144;
        f32x4 gs[8], sh[8];
#pragma unroll
        for (int j = 0; j < 8; ++j) { const int c = 4 * (lane + 64 * j); gs[j] = *(const f32x4*)(g + c) * (*(const f32x4*)(mb + 2048 + c) + 1.f); sh[j] = *(const f32x4*)(mb + c); }
        f32x4 v[8], vn[8];
        { const f32x4* xr = (const f32x4*)(x + (size_t)row0 * D);
#pragma unroll
          for (int j = 0; j < 8; ++j) v[j] = xr[lane + 64 * j]; }
#pragma unroll 1
        for (int rr = 0; rr < 8; ++rr) {
            const int row = row0 + rr;
            if (rr < 7) { const f32x4* xr = (const f32x4*)(x + (size_t)(row + 1) * D);
#pragma unroll
                for (int j = 0; j < 8; ++j) vn[j] = xr[lane + 64 * j]; }
            float s = 0.f;
#pragma unroll
            for (int j = 0; j < 8; ++j) s += v[j][0] * v[j][0] + v[j][1] * v[j][1] + v[j][2] * v[j][2] + v[j][3] * v[j][3];
            s = wave_sum(s, lane);
            const float r = rsqrtf(s * (1.f / D) + 1e-6f);
#pragma unroll
            for (int j = 0; j < 8; ++j) {
                const f32x4 o = (v[j] * r) * gs[j] + sh[j];
                u32x2 w; w.x = cvt_pk_bf16(o[0], o[1]); w.y = cvt_pk_bf16(o[2], o[3]);
                *(u32x2*)(h + (size_t)row * D + 4 * (lane + 64 * j)) = w;
            }
#pragma unroll
            for (int j = 0; j < 8; ++j) v[j] = vn[j];
        }
    }
}
__device__ __forceinline__ void final_rms_phase(float* xo0, const float* g0) {
    float* xo = launder(xo0); const float* g = launder(g0);
    const int tid_ = opaque_tid(); const int lane = tid_ & 63, gw = blockIdx.x * 8 + (tid_ >> 6), nw = gridDim.x * 8;
    f32x4 gg[8];
#pragma unroll
    for (int j = 0; j < 8; ++j) gg[j] = *(const f32x4*)(g + 4 * (lane + 64 * j));
    f32x4 v[8], vn[8];
    if (gw < NTOK) { const f32x4* xr = (const f32x4*)(xo + (size_t)gw * D);
#pragma unroll
        for (int j = 0; j < 8; ++j) v[j] = xr[lane + 64 * j]; }
    for (int row = gw; row < NTOK; row += nw) {
        const int nrow = row + nw;
        if (nrow < NTOK) { const f32x4* xn = (const f32x4*)(xo + (size_t)nrow * D);
#pragma unroll
            for (int j = 0; j < 8; ++j) vn[j] = xn[lane + 64 * j]; }
        f32x4* xr = (f32x4*)(xo + (size_t)row * D);
        float s = 0.f;
#pragma unroll
        for (int j = 0; j < 8; ++j) s += v[j][0] * v[j][0] + v[j][1] * v[j][1] + v[j][2] * v[j][2] + v[j][3] * v[j][3];
        s = wave_sum(s, lane);
        const float r = rsqrtf(s * (1.f / D) + 1e-6f);
#pragma unroll
        for (int j = 0; j < 8; ++j) xr[lane + 64 * j] = (v[j] * r) * gg[j];
#pragma unroll
        for (int j = 0; j < 8; ++j) v[j] = vn[j];
    }
}

__device__ __forceinline__ void amix_item(const KP p, int layer, LAS unsigned char* lds, int item) {
    unsigned char* ws = launder(p->ws);
    const int tid = opaque_tid(), wave = tid >> 6, lane = tid & 63;
    const int g = item & 7, ch = (item >> 3) & 15, b = item >> 7;
    const int T0 = b * 2048 + ch * 128, c0 = g * 256;
    LAS unsigned char* VT = lds;
    LAS unsigned char* WS_ = lds + 65536;
    LAS float* MR = (LAS float*)(lds + 98304);
    const float* st = (const float*)(ws + WS_STATP);
    {
        typedef float f32x2v __attribute__((ext_vector_type(2)));
        LAS float* RED = (LAS float*)(lds + 99328);
        const int t = tid & 127, pg = tid >> 7;
        f32x2v pv[8];
#pragma unroll
        for (int k = 0; k < 8; ++k) pv[k] = *(const f32x2v*)(st + ((size_t)(pg * 8 + k) * NTOK + T0 + t) * 2);
        float s = 0.f, q = 0.f;
#pragma unroll
        for (int k = 0; k < 8; ++k) { s += pv[k][0]; q += pv[k][1]; }
        RED[(pg * 128 + t) * 2] = s; RED[(pg * 128 + t) * 2 + 1] = q;
    }
    { const bf16_t* wsm = (const bf16_t*)(ws + WS_WSM) + (size_t)(layer * 8 + g) * 16384;
#pragma unroll
      for (int i = 0; i < 4; ++i) { const int c = tid + 512 * i, row = c >> 4, chn = c & 15;
          *(LAS u32x4*)(WS_ + row * 256 + ((chn ^ (row & 15)) << 4)) = *(const u32x4*)(wsm + row * 128 + chn * 8); } }
    block_sync();
    if (tid < 128) { const LAS float* RED = (const LAS float*)(lds + 99328); float s = 0.f, q = 0.f;
#pragma unroll
        for (int k = 0; k < 4; ++k) { s += RED[(k * 128 + tid) * 2]; q += RED[(k * 128 + tid) * 2 + 1]; }
        const float mean = s * (1.f / 2048.f); const float var = fmaxf(q * (1.f / 2048.f) - mean * mean, 0.f);
        MR[tid * 2] = mean; MR[tid * 2 + 1] = rsqrtf(var + 1e-6f); }
    block_sync();
    { const bf16_t* V = (const bf16_t*)(ws + WS_V);
      const float* lng = p->in[I_ALNG] + (size_t)layer * 2048 + c0; const float* lnb = p->in[I_ALNB] + (size_t)layer * 2048 + c0;
#pragma unroll
      for (int i = 0; i < 4; ++i) {
          const int id = tid + 512 * i, cg8 = id & 31, tp = id >> 5;
          const u32x4 a = *(const u32x4*)(V + (size_t)(T0 + 2 * tp) * 2048 + c0 + cg8 * 8), bq = *(const u32x4*)(V + (size_t)(T0 + 2 * tp + 1) * 2048 + c0 + cg8 * 8);
          const float m0 = MR[4 * tp], r0 = MR[4 * tp + 1], m1 = MR[4 * tp + 2], r1 = MR[4 * tp + 3];
          const f32x4 g0 = *(const f32x4*)(lng + cg8 * 8), g1 = *(const f32x4*)(lng + cg8 * 8 + 4), b0 = *(const f32x4*)(lnb + cg8 * 8), b1 = *(const f32x4*)(lnb + cg8 * 8 + 4);
          const unsigned aw[4] = {a.x, a.y, a.z, a.w}, bw[4] = {bq.x, bq.y, bq.z, bq.w};
#pragma unroll
          for (int j = 0; j < 8; ++j) {
              const float gg = j < 4 ? g0[j & 3] : g1[j & 3], bb = j < 4 ? b0[j & 3] : b1[j & 3];
              const float x0 = (j & 1) ? bf_hi(aw[j >> 1]) : bf_lo(aw[j >> 1]), x1 = (j & 1) ? bf_hi(bw[j >> 1]) : bf_lo(bw[j >> 1]);
              const int c = cg8 * 8 + j;
              *(LAS unsigned*)(VT + c * 256 + (((tp >> 2) ^ ((c ^ (c >> 3)) & 15)) << 4) + (tp & 3) * 4) = cvt_pk_bf16((x0 - m0) * r0 * gg + bb, (x1 - m1) * r1 * gg + bb);
          }
      } }
    block_sync();
    f32x4 acc[2][8];
#pragma unroll
    for (int mi = 0; mi < 2; ++mi)
#pragma unroll
        for (int ni = 0; ni < 8; ++ni) acc[mi][ni] = (f32x4){0.f, 0.f, 0.f, 0.f};
    const int fr = lane & 15, fq = lane >> 4;
#pragma unroll
    for (int ks = 0; ks < 4; ++ks) {
        bf16x8 af[2];
#pragma unroll
        for (int mi = 0; mi < 2; ++mi) { const int c = wave * 32 + mi * 16 + fr; af[mi] = *(const LAS bf16x8*)(VT + c * 256 + (((4 * ks + fq) ^ ((c ^ (c >> 3)) & 15)) << 4)); }
#pragma unroll
        for (int ni = 0; ni < 8; ++ni) {
            if (ks <= (ni >> 1)) {
                const int t = ni * 16 + fr; const bf16x8 bfr = *(const LAS bf16x8*)(WS_ + t * 256 + (((4 * ks + fq) ^ (t & 15)) << 4));
#pragma unroll
                for (int mi = 0; mi < 2; ++mi) acc[mi][ni] = __builtin_amdgcn_mfma_f32_16x16x32_bf16(af[mi], bfr, acc[mi][ni], 0, 0, 0);
            }
        }
    }
    { bf16_t* U = (bf16_t*)(ws + WS_U); const bf16_t* SG = (const bf16_t*)(ws + WS_SG); const float* bs = p->in[I_ABS] + (size_t)(layer * 8 + g) * 128;
      u32x2 uu[8][2], sg[8][2]; float bsv[8];
#pragma unroll
      for (int ni = 0; ni < 8; ++ni) {
          const int t = ni * 16 + fr; bsv[ni] = bs[t];
#pragma unroll
          for (int mi = 0; mi < 2; ++mi) { const size_t off = (size_t)(T0 + t) * 2048 + c0 + wave * 32 + mi * 16 + 4 * fq; uu[ni][mi] = *(const u32x2*)(U + off); sg[ni][mi] = *(const u32x2*)(SG + off); }
      }
#pragma unroll
      for (int ni = 0; ni < 8; ++ni) {
          const int t = ni * 16 + fr;
#pragma unroll
          for (int mi = 0; mi < 2; ++mi) {
              const size_t off = (size_t)(T0 + t) * 2048 + c0 + wave * 32 + mi * 16 + 4 * fq;
              const f32x4 a = acc[mi][ni]; const u32x2 u2 = uu[ni][mi], s2 = sg[ni][mi]; const float bv = bsv[ni];
              u32x2 o; o.x = cvt_pk_bf16(gelu_f(bf_lo(u2.x)) * (a[0] + bv) * silu_f(bf_lo(s2.x)), gelu_f(bf_hi(u2.x)) * (a[1] + bv) * silu_f(bf_hi(s2.x)));
              o.y = cvt_pk_bf16(gelu_f(bf_lo(u2.y)) * (a[2] + bv) * silu_f(bf_lo(s2.y)), gelu_f(bf_hi(u2.y)) * (a[3] + bv) * silu_f(bf_hi(s2.y)));
              *(u32x2*)(U + off) = o;
          }
      } }
    block_sync();
}

template <int WSZ>
__device__ __forceinline__ void cpool_body(const bf16_t* XW, bf16_t* SGC, const f32x4 l0, const f32x4 l1, const int t0) {
    u32x4 xw[8 + WSZ - 1], gq[8];
#pragma unroll
    for (int j = 0; j < WSZ - 1; ++j) { const int u = t0 - (WSZ - 1) + j; xw[j] = u >= 0 ? *(const u32x4*)(XW + (size_t)u * 2048) : (u32x4){0u, 0u, 0u, 0u}; }
#pragma unroll
    for (int i = 0; i < 8; ++i) { xw[WSZ - 1 + i] = *(const u32x4*)(XW + (size_t)(t0 + i) * 2048); gq[i] = *(const u32x4*)(SGC + (size_t)(t0 + i) * 2048); }
    float sum[8];
#pragma unroll
    for (int j = 0; j < 8; ++j) sum[j] = 0.f;
#pragma unroll
    for (int j = 0; j < WSZ - 1; ++j) { const u32x4 w = xw[j];
        sum[0] += bf_lo(w.x); sum[1] += bf_hi(w.x); sum[2] += bf_lo(w.y); sum[3] += bf_hi(w.y); sum[4] += bf_lo(w.z); sum[5] += bf_hi(w.z); sum[6] += bf_lo(w.w); sum[7] += bf_hi(w.w); }
#pragma unroll
    for (int i = 0; i < 8; ++i) {
        const u32x4 w = xw[WSZ - 1 + i], g4 = gq[i], w2 = xw[i];
        const float xv[8] = {bf_lo(w.x), bf_hi(w.x), bf_lo(w.y), bf_hi(w.y), bf_lo(w.z), bf_hi(w.z), bf_lo(w.w), bf_hi(w.w)};
        const float gv[8] = {silu_f(bf_lo(g4.x)), silu_f(bf_hi(g4.x)), silu_f(bf_lo(g4.y)), silu_f(bf_hi(g4.y)), silu_f(bf_lo(g4.z)), silu_f(bf_hi(g4.z)), silu_f(bf_lo(g4.w)), silu_f(bf_hi(g4.w))};
        const float ov[8] = {bf_lo(w2.x), bf_hi(w2.x), bf_lo(w2.y), bf_hi(w2.y), bf_lo(w2.z), bf_hi(w2.z), bf_lo(w2.w), bf_hi(w2.w)};
        const float inv = 1.f / (float)min(t0 + i + 1, WSZ);
        float o[8];
#pragma unroll
        for (int j = 0; j < 8; ++j) { sum[j] += xv[j]; o[j] = (sum[j] * inv - xv[j]) * (j < 4 ? l0[j & 3] : l1[j & 3]) * gv[j]; sum[j] -= ov[j]; }
        u32x4 ow; ow.x = cvt_pk_bf16(o[0], o[1]); ow.y = cvt_pk_bf16(o[2], o[3]); ow.z = cvt_pk_bf16(o[4], o[5]); ow.w = cvt_pk_bf16(o[6], o[7]);
        *(u32x4*)(SGC + (size_t)(t0 + i) * 2048) = ow;
    }
}
__device__ __forceinline__ void cpool_item(const KP p, int layer, int item) {
    unsigned char* ws = launder(p->ws);
    const int tid_ = opaque_tid(); const int wave = tid_ >> 6, lane = tid_ & 63;
    const int gi = item & 3, tt = (item >> 2) & 15, b = item >> 6;
    const int c = gi * 512 + lane * 8;
    const bf16_t* XW = (const bf16_t*)(ws + WS_XW) + (size_t)b * 2048 * 2048 + c;
    bf16_t* SGC = (bf16_t*)(ws + WS_SGC) + (size_t)b * 2048 * 2048 + c;
    const float* ls = p->in[I_CSCALE] + (size_t)layer * 2048 + c;
    const f32x4 l0 = *(const f32x4*)ls, l1 = *(const f32x4*)(ls + 4);
    const int t0 = tt * 128 + wave * 16;
    for (int hf = 0; hf < 2; ++hf) {
        if (gi == 0) cpool_body<2>(XW, SGC, l0, l1, t0 + 8 * hf);
        else if (gi == 1) cpool_body<4>(XW, SGC, l0, l1, t0 + 8 * hf);
        else if (gi == 2) cpool_body<8>(XW, SGC, l0, l1, t0 + 8 * hf);
        else cpool_body<16>(XW, SGC, l0, l1, t0 + 8 * hf);
    }
}

#if EN_B
constexpr int A_KB = 0, A_VB = 32768, A_BT = 65536, A_IMPH = 67584, A_IMPF = 101376, A_SEL = 109824, A_UNI = 110080;
__device__ __forceinline__ int kperm(int r) { return (r & ~12) | ((r & 8) >> 1) | ((r & 4) << 1); }
__device__ __forceinline__ int t5_bucket(int n) { if (n < 16) return n; const int v = 16 + (int)(logf((float)n * (1.f / 16.f)) / 2.0794415416798357f * 16.f); return v < 31 ? v : 31; }
__device__ __forceinline__ bf16x8 pack_frag(const f32x16& v, int s2) {
    u32x4 w; w.x = cvt_pk_bf16(v[8 * s2 + 0], v[8 * s2 + 1]); w.y = cvt_pk_bf16(v[8 * s2 + 2], v[8 * s2 + 3]); w.z = cvt_pk_bf16(v[8 * s2 + 4], v[8 * s2 + 5]); w.w = cvt_pk_bf16(v[8 * s2 + 6], v[8 * s2 + 7]);
    return __builtin_bit_cast(bf16x8, w);
}
#define ZERO16 ((f32x16){0.f,0.f,0.f,0.f,0.f,0.f,0.f,0.f,0.f,0.f,0.f,0.f,0.f,0.f,0.f,0.f})

__device__ __forceinline__ void kcvc_item(const KP p, const int layer, const int bg, const int isel) {
    unsigned char* ws = launder(p->ws);
    const int tid = opaque_tid(), wave = __builtin_amdgcn_readfirstlane(tid >> 6), lane = tid & 63, r = lane & 31, h = lane >> 5;
    unsigned char* img = ws + WS_KCI + (size_t)bg * 32768;
    {
        const int nb = wave & 3, dh = wave >> 2;
        {
            const int n = nb * 32 + r;
            const float nmask = n < 127 ? 1.f : 0.f;
#pragma unroll
            for (int i = 0; i < 2; ++i) {
                if (i != isel) continue;
                const float* Pr = (const float*)(ws + WS_PQ) + (size_t)i * 4096 * 256 + (size_t)(bg * 128 + n) * 256;
                const float* b1 = (const float*)(ws + WS_BIAS1) + (layer * 2 + i) * 128;
                const bf16_t* w2 = (const bf16_t*)(ws + WS_W2T) + (size_t)(layer * 2 + i) * 16384;
                f32x16 a0 = ZERO16, a1 = ZERO16;
#pragma unroll
                for (int ks = 0; ks < 8; ++ks) {
                    const int e0 = 16 * ks + 8 * h;
                    const f32x4 pa = *(const f32x4*)(Pr + e0), pb = *(const f32x4*)(Pr + e0 + 4), qa = *(const f32x4*)(Pr + 384 + e0), qb = *(const f32x4*)(Pr + 384 + e0 + 4);
                    const f32x4 ba = *(const f32x4*)(b1 + e0), bb = *(const f32x4*)(b1 + e0 + 4);
                    f32x4 x0 = pa + qa + ba, x1 = pb + qb + bb;
#pragma unroll
                    for (int j = 0; j < 4; ++j) { x0[j] = gelu_f(x0[j]) * nmask; x1[j] = gelu_f(x1[j]) * nmask; }
                    const bf16x8 hf = __builtin_bit_cast(bf16x8, pack8(x0, x1));
                    const bf16x8 w0 = *(const bf16x8*)(w2 + (size_t)(dh * 64 + r) * 128 + e0), w1 = *(const bf16x8*)(w2 + (size_t)(dh * 64 + 32 + r) * 128 + e0);
                    if (i == 0) { a0 = __builtin_amdgcn_mfma_f32_32x32x16_bf16(w0, hf, a0, 0, 0, 0); a1 = __builtin_amdgcn_mfma_f32_32x32x16_bf16(w1, hf, a1, 0, 0, 0); }
                    else { a0 = __builtin_amdgcn_mfma_f32_32x32x16_bf16(hf, w0, a0, 0, 0, 0); a1 = __builtin_amdgcn_mfma_f32_32x32x16_bf16(hf, w1, a1, 0, 0, 0); }
                }
#pragma unroll
                for (int dbl = 0; dbl < 2; ++dbl) {
                    const f32x16& a = dbl ? a1 : a0;
#pragma unroll
                    for (int aa = 0; aa < 4; ++aa) {
                        u32x2 w; w.x = cvt_pk_bf16(a[4 * aa], a[4 * aa + 1]); w.y = cvt_pk_bf16(a[4 * aa + 2], a[4 * aa + 3]);
                        if (i == 0) { const int chunk = dh * 8 + dbl * 4 + aa; *(u32x2*)(img + chunk * 2048 + n * 16 + 8 * h) = w; }
                        else { const int d = dh * 64 + dbl * 32 + r, chunk = nb * 4 + aa; *(u32x2*)(img + 32 * 32768 + chunk * 2048 + d * 16 + 8 * h) = w; }
                    }
                }
            }
        }
    }
}
__device__ __forceinline__ void attn_item(const KP p, const int layer, LAS unsigned char* lds, const int b, const int g, const int qi, unsigned* qctr) {
    unsigned char* ws = launder(p->ws);
    const int tid = opaque_tid(), wave = __builtin_amdgcn_readfirstlane(tid >> 6), lane = tid & 63, r = lane & 31, h = lane >> 5;
    const int hl = wave >> 1, head = g * 4 + hl, qh = wave & 1;
    const int t0 = qi * 64, ql = qh * 32 + r, tq = t0 + ql, bg = b * 4 + g;
    const size_t tok = (size_t)b * 2048 + tq;
    LAS float* BT = (LAS float*)(lds + A_BT);
    LAS float* IMPH = (LAS float*)(lds + A_IMPH);
    LAS float* IMPF = (LAS float*)(lds + A_IMPF);
    LAS unsigned* SEL = (LAS unsigned*)(lds + A_SEL);
    LAS unsigned* UNI = (LAS unsigned*)(lds + A_UNI);
#if defined(ATT_NO_CMP) || defined(ATT_NO_SEL)
    const bool dosel = false;
#else
    const bool dosel = qi >= 16;
#endif
    for (int e = tid; e < 4 * 64 * 33; e += 512) IMPH[e] = 0.f;
    if (tid < 64) SEL[tid] = dosel ? 0u : 0xffffffffu;
    if (tid == 64) UNI[0] = dosel ? 0u : 0xffffffffu;
    { const int hh = tid >> 7, dist = tid & 127; BT[tid] = p->in[I_RELB][t5_bucket(dist) * 16 + g * 4 + hh] * LOG2E; }
    bf16x8 qf[8];
    { const bf16_t* Qp = (const bf16_t*)(ws + WS_Q) + tok * 2048 + head * 128 + h * 8;
#pragma unroll
      for (int kk = 0; kk < 8; ++kk) qf[kk] = *(const bf16x8*)(Qp + kk * 16); }
    unsigned qv = 0u;
    if (tid == 0) qv = __hip_atomic_fetch_add(qctr, 1u, __ATOMIC_RELAXED, __HIP_MEMORY_SCOPE_AGENT);
#ifdef ATT_NO_CMP
    const int nblk = 0;
#else
    const int nblk = min(4, (4 * qi + 3 + 31) >> 5);
#endif
    { const bf16_t* kci = (const bf16_t*)(ws + WS_KCI) + (size_t)bg * 16384 + wave * 2048 + lane * 8;
#pragma unroll
      for (int i_ = 0; i_ < 4; ++i_) __builtin_amdgcn_global_load_lds((const unsigned*)(kci + i_ * 512), (LAS unsigned*)(lds + A_KB + (wave * 4 + i_) * 1024), 16, 0, 0);
#pragma unroll
      for (int i_ = 0; i_ < 4; ++i_) __builtin_amdgcn_global_load_lds((const unsigned*)(kci + (size_t)32 * 16384 + i_ * 512), (LAS unsigned*)(lds + A_VB + (wave * 4 + i_) * 1024), 16, 0, 0); }
    block_sync();
    if (tid == 0) *(volatile LAS unsigned*)(lds + 135936) = qv;
    const LAS float* BTh = BT + hl * 128;
    const int kcbase = kperm(r) * 16 + h * 2048, vbase = r * 16 + h * 2048, ktbase = kperm(r) * 16 + h * 1024;
    unsigned ofp[4][8];
    f32x16 oacc[4];
    {
        f32x16 sc[4];
        float mx = -1e30f;
#pragma unroll
        for (int kb = 0; kb < 4; ++kb) {
            sc[kb] = ZERO16;
            if (kb < nblk) {
#pragma unroll
                for (int kk = 0; kk < 8; ++kk) { const bf16x8 a = *(const LAS bf16x8*)(lds + A_KB + kcbase + kb * 512 + kk * 4096); sc[kb] = __builtin_amdgcn_mfma_f32_32x32x16_bf16(a, qf[kk], sc[kb], 0, 0, 0); }
                float bias[16];
#pragma unroll
                for (int i = 0; i < 16; ++i) { const int n = 32 * kb + 16 * (i >> 3) + 8 * h + (i & 7); const int dist = tq - (16 * n + 31); bias[i] = BTh[min(max(dist, 0), 127)]; }
#pragma unroll
                for (int i = 0; i < 16; ++i) asm volatile("" : "+v"(bias[i]));
#pragma unroll
                for (int i = 0; i < 16; ++i) {
                    const int n = 32 * kb + 16 * (i >> 3) + 8 * h + (i & 7);
                    const int dist = tq - (16 * n + 31);
                    const float s = dist >= 0 ? sc[kb][i] + bias[i] : -1e30f;
                    sc[kb][i] = s; mx = fmaxf(mx, s);
                }
            }
        }
        mx = fmaxf(mx, shfl_xor_l(mx, 32, lane));
        float l = 0.f;
#pragma unroll
        for (int kb = 0; kb < 4; ++kb) if (kb < nblk) {
#pragma unroll
            for (int i = 0; i < 16; ++i) { const float s = sc[kb][i]; const float pv = s > -1e29f ? __builtin_amdgcn_exp2f(s - mx) : 0.f; sc[kb][i] = pv; l += pv; }
        }
        l += shfl_xor_l(l, 32, lane);
        const float inv = l > 0.f ? 1.f / l : 0.f;
#pragma unroll
        for (int db = 0; db < 4; ++db) oacc[db] = ZERO16;
#pragma unroll
        for (int kb = 0; kb < 4; ++kb) if (kb < nblk) {
            sc[kb] = sc[kb] * inv;
            if (dosel) {
#pragma unroll
                for (int s2 = 0; s2 < 2; ++s2) {
                    LAS float* ip = IMPH + (hl * 64 + ql) * 33 + 8 * kb + 4 * s2 + 2 * h;
                    const float a = (sc[kb][8 * s2] + sc[kb][8 * s2 + 1]) + (sc[kb][8 * s2 + 2] + sc[kb][8 * s2 + 3]);
                    const float bq = ((sc[kb][8 * s2 + 4] + sc[kb][8 * s2 + 5]) + (sc[kb][8 * s2 + 6] + sc[kb][8 * s2 + 7])) + sc[kb][8 * s2 + 3];
                    __hip_atomic_fetch_add(ip, a, __ATOMIC_RELAXED, __HIP_MEMORY_SCOPE_WORKGROUP);
                    __hip_atomic_fetch_add(ip + 1, bq, __ATOMIC_RELAXED, __HIP_MEMORY_SCOPE_WORKGROUP);
                    __hip_atomic_fetch_add(ip + 2, sc[kb][8 * s2 + 7], __ATOMIC_RELAXED, __HIP_MEMORY_SCOPE_WORKGROUP);
                }
            }
#pragma unroll
            for (int s2 = 0; s2 < 2; ++s2) {
                const bf16x8 pf = pack_frag(sc[kb], s2);
#pragma unroll
                for (int db = 0; db < 4; ++db) { const bf16x8 a = *(const LAS bf16x8*)(lds + A_VB + vbase + (4 * kb + 2 * s2) * 2048 + db * 512); oacc[db] = __builtin_amdgcn_mfma_f32_32x32x16_bf16(a, pf, oacc[db], 0, 0, 0); }
            }
        }
        { const float g0 = ((const float*)(ws + WS_GS))[tok * 48 + head];
#pragma unroll
          for (int db = 0; db < 4; ++db) {
#pragma unroll
              for (int k = 0; k < 8; ++k) ofp[db][k] = cvt_pk_bf16(oacc[db][2 * k] * g0, oacc[db][2 * k + 1] * g0);
              oacc[db] = ZERO16; } }
    }
    block_sync();
    const bf16_t* KVp = (const bf16_t*)(ws + WS_KV);
    const unsigned ldoff = (unsigned)(wave * 1024 + lane * 8);
#define ATT_ISSUE(br_, s_, buf_) do { const bf16_t* Kt_ = KVp + (size_t)((br_) == 1 ? 2 : 4) * KV_SLAB + ((size_t)bg * 32 + (s_)) * 8192 + ldoff; \
        const bf16_t* Vt_ = KVp + (size_t)((br_) == 1 ? 3 : 5) * KV_SLAB + ((size_t)bg * 32 + (s_)) * 8192 + ldoff; \
        _Pragma("unroll") for (int i_ = 0; i_ < 2; ++i_) __builtin_amdgcn_global_load_lds((const unsigned*)(Kt_ + i_ * 512), (LAS unsigned*)(lds + A_KB + (buf_) * 16384 + (wave * 2 + i_) * 1024), 16, 0, 0); \
        _Pragma("unroll") for (int i_ = 0; i_ < 2; ++i_) __builtin_amdgcn_global_load_lds((const unsigned*)(Vt_ + i_ * 512), (LAS unsigned*)(lds + A_VB + (buf_) * 16384 + (wave * 2 + i_) * 1024), 16, 0, 0); } while (0)
    ATT_ISSUE(1, 0, 0);
    if (dosel) {
        const int q = tid >> 3, sg = tid & 7, tqq = t0 + q;
#pragma unroll
        for (int j = 0; j < 4; ++j) { const int s = sg * 4 + j;
            float v = (IMPH[(0 * 64 + q) * 33 + s] + IMPH[(1 * 64 + q) * 33 + s]) + (IMPH[(2 * 64 + q) * 33 + s] + IMPH[(3 * 64 + q) * 33 + s]);
            const bool fut = s * 64 > tqq, forced = (s == 0) || (s == qi) || (s == qi - 1);
            IMPF[q * 33 + s] = fut ? -1.f : (v + (forced ? 1e4f : 0.f)); }
        asm volatile("s_waitcnt lgkmcnt(0)" ::: "memory"); __builtin_amdgcn_s_barrier(); asm volatile("" ::: "memory");
        unsigned bits = 0;
        { float ov[32];
#pragma unroll
          for (int s2 = 0; s2 < 32; ++s2) ov[s2] = IMPF[q * 33 + s2];
#pragma unroll
          for (int j = 0; j < 4; ++j) { const int s = sg * 4 + j; const float v = IMPF[q * 33 + s]; int cnt = 0;
#pragma unroll
              for (int s2 = 0; s2 < 32; ++s2) cnt += (ov[s2] > v || (ov[s2] == v && s2 < s)) ? 1 : 0;
              if (cnt < 16) bits |= 1u << s; } }
        __hip_atomic_fetch_or(SEL + q, bits, __ATOMIC_RELAXED, __HIP_MEMORY_SCOPE_WORKGROUP);
        __hip_atomic_fetch_or(UNI, bits, __ATOMIC_RELAXED, __HIP_MEMORY_SCOPE_WORKGROUP);
    }
    block_sync();
    const unsigned selw = SEL[ql];
    const unsigned uni = (unsigned)__builtin_amdgcn_readfirstlane((int)UNI[0]);
    const unsigned causal_blocks = qi == 31 ? 0xffffffffu : ((2u << qi) - 1u);
    const float b31 = BTh[127];
    constexpr float MASKV = -30000.f, MINIT = -20000.f;
    float m = MINIT, l = 0.f;
    int br = 1, s = 0, buf = 0;
    while (br != 3) {
        int nbr, ns;
        if (br == 1) { const unsigned mk = uni & causal_blocks & ~((2u << s) - 1u); if (s < 31 && mk) { nbr = 1; ns = __builtin_ctz(mk); } else { nbr = 2; ns = max(0, qi - 8); } }
        else { if (s + 1 <= qi) { nbr = 2; ns = s + 1; } else { nbr = 3; ns = 0; } }
        if (nbr != 3) ATT_ISSUE(nbr, ns, buf ^ 1);
        const int kbase = s * 64;
        const bool need_elem = (kbase + 63 + 128 > t0) || (br == 2 && (t0 + 63 - kbase >= 512));
        const bool lanebit = br == 1 ? ((selw >> s) & 1u) != 0u : true;
        if (__builtin_amdgcn_ballot_w64(lanebit) != 0ull) {
        f32x16 sc[2];
        float mx = -1e30f;
        sc[0] = ZERO16; sc[1] = ZERO16;
        {
            const LAS unsigned char* kp = lds + A_KB + buf * 16384 + ktbase;
            bf16x8 ka[4][2];
#pragma unroll
            for (int kk = 0; kk < 4; ++kk) { ka[kk][0] = *(const LAS bf16x8*)(kp + kk * 2048); ka[kk][1] = *(const LAS bf16x8*)(kp + 512 + kk * 2048); }
#pragma unroll
            for (int kk = 0; kk < 8; ++kk) {
                sc[0] = __builtin_amdgcn_mfma_f32_32x32x16_bf16(ka[kk & 3][0], qf[kk], sc[0], 0, 0, 0);
                sc[1] = __builtin_amdgcn_mfma_f32_32x32x16_bf16(ka[kk & 3][1], qf[kk], sc[1], 0, 0, 0);
                if (kk < 4) { ka[kk][0] = *(const LAS bf16x8*)(kp + (kk + 4) * 2048); ka[kk][1] = *(const LAS bf16x8*)(kp + 512 + (kk + 4) * 2048); }
            }
        }
        float alpha, ls = 0.f;
        if (need_elem) {
            const int wlim = br == 1 ? 0x7fffffff : 512;
#pragma unroll
            for (int kb = 0; kb < 2; ++kb) {
                float bias[16];
#pragma unroll
                for (int i = 0; i < 16; ++i) { const int key = kbase + 32 * kb + 16 * (i >> 3) + 8 * h + (i & 7); bias[i] = BTh[min(max(tq - key, 0), 127)]; }
#pragma unroll
                for (int i = 0; i < 16; ++i) asm volatile("" : "+v"(bias[i]));
#pragma unroll
                for (int i = 0; i < 16; ++i) {
                    const int key = kbase + 32 * kb + 16 * (i >> 3) + 8 * h + (i & 7);
                    const int dist = tq - key;
                    const float sv = (lanebit && dist >= 0 && dist < wlim) ? sc[kb][i] + bias[i] : MASKV;
                    sc[kb][i] = sv; mx = fmaxf(mx, sv);
                }
            }
            mx = fmaxf(mx, shfl_xor_l(mx, 32, lane));
            const float mnew = fmaxf(m, mx);
            alpha = __builtin_amdgcn_exp2f(m - mnew);
            m = mnew;
#pragma unroll
            for (int kb = 0; kb < 2; ++kb)
#pragma unroll
                for (int i = 0; i < 16; ++i) { const float pv = __builtin_amdgcn_exp2f(sc[kb][i] - mnew); sc[kb][i] = pv; ls += pv; }
        } else {
            const float bl = lanebit ? b31 : MASKV;
#pragma unroll
            for (int kb = 0; kb < 2; ++kb)
#pragma unroll
                for (int i = 0; i < 16; ++i) mx = fmaxf(mx, sc[kb][i]);
            mx = fmaxf(mx, shfl_xor_l(mx, 32, lane));
            const float mnew = fmaxf(m, mx + bl);
            alpha = __builtin_amdgcn_exp2f(m - mnew);
            m = mnew;
            const float cc = bl - mnew;
#pragma unroll
            for (int kb = 0; kb < 2; ++kb)
#pragma unroll
                for (int i = 0; i < 16; ++i) { const float pv = __builtin_amdgcn_exp2f(sc[kb][i] + cc); sc[kb][i] = pv; ls += pv; }
        }
        l = l * alpha + ls;
        if (__builtin_amdgcn_ballot_w64(alpha != 1.f) != 0ull) {
#pragma unroll
            for (int db = 0; db < 4; ++db) oacc[db] = oacc[db] * alpha;
        }
        {
            const LAS unsigned char* vp = lds + A_VB + buf * 16384 + vbase;
            bf16x8 va[2][4];
#pragma unroll
            for (int gq = 0; gq < 2; ++gq)
#pragma unroll
                for (int db = 0; db < 4; ++db) va[gq][db] = *(const LAS bf16x8*)(vp + (2 * gq) * 2048 + db * 512);
#pragma unroll
            for (int gq = 0; gq < 4; ++gq) {
                const bf16x8 pf = pack_frag(sc[gq >> 1], gq & 1);
#pragma unroll
                for (int db = 0; db < 4; ++db) {
                    oacc[db] = __builtin_amdgcn_mfma_f32_32x32x16_bf16(va[gq & 1][db], pf, oacc[db], 0, 0, 0);
                    if (gq < 2) va[gq & 1][db] = *(const LAS bf16x8*)(vp + (2 * (gq + 2)) * 2048 + db * 512);
                }
            }
            __builtin_amdgcn_sched_group_barrier(0x100, 8, 0);
#pragma unroll
            for (int q_ = 0; q_ < 8; ++q_) { __builtin_amdgcn_sched_group_barrier(0x008, 1, 0); __builtin_amdgcn_sched_group_barrier(0x100, 1, 0); }
            __builtin_amdgcn_sched_group_barrier(0x008, 8, 0);
        }
        }
        if (nbr != br) {
            const float lt = l + shfl_xor_l(l, 32, lane);
            const float wgt = (lt > 0.f ? 1.f / lt : 0.f) * ((const float*)(ws + WS_GS))[tok * 48 + head + (br == 1 ? 16 : 32)];
#pragma unroll
            for (int db = 0; db < 4; ++db) {
#pragma unroll
                for (int k = 0; k < 8; ++k) ofp[db][k] = cvt_pk_bf16(bf_lo(ofp[db][k]) + oacc[db][2 * k] * wgt, bf_hi(ofp[db][k]) + oacc[db][2 * k + 1] * wgt);
                oacc[db] = ZERO16; }
            m = MINIT; l = 0.f;
        }
        block_sync();
        br = nbr; s = ns; buf ^= 1;
    }
    { const int tid2 = opaque_tid(); const int r2 = tid2 & 31, h2 = (tid2 >> 5) & 1;
      bf16_t* SGBp = (bf16_t*)(launder(p->ws) + WS_SGB) + ((size_t)b * 2048 + t0 + qh * 32 + r2) * 2048 + head * 128 + 4 * h2;
      u32x2 gq[4][4];
#pragma unroll
      for (int db = 0; db < 4; ++db)
#pragma unroll
          for (int aa = 0; aa < 4; ++aa) gq[db][aa] = *(const u32x2*)(SGBp + 32 * db + 8 * aa);
#pragma unroll
      for (int db = 0; db < 4; ++db)
#pragma unroll
          for (int aa = 0; aa < 4; ++aa) {
              bf16_t* po = SGBp + 32 * db + 8 * aa + (WS_XW - WS_SGB) / 2;
              const u32x2 g2 = gq[db][aa];
              u32x2 o; o.x = cvt_pk_bf16(bf_lo(ofp[db][2 * aa]) * silu_f(bf_lo(g2.x)), bf_hi(ofp[db][2 * aa]) * silu_f(bf_hi(g2.x))); o.y = cvt_pk_bf16(bf_lo(ofp[db][2 * aa + 1]) * silu_f(bf_lo(g2.y)), bf_hi(ofp[db][2 * aa + 1]) * silu_f(bf_hi(g2.y)));
              *(u32x2*)po = o;
          } }
#undef ATT_ISSUE
}
__device__ __forceinline__ void attn_phase(const KP p, int layer, LAS unsigned char* lds) {
    const int G = gridDim.x, c = blockIdx.x, x = c & 7;
    const int nbx = (G - x + 7) >> 3;
    unsigned* qctr = (unsigned*)(launder(p->ws) + WS_BAR) + 3584 + (layer * 8 + x) * 32;
    int j = c >> 3;
    while (j < 128) {
        const int qi = 31 - (j >> 2), bg = ((j & 3) << 3) + x;
        attn_item(p, layer, lds, bg >> 2, bg & 3, qi, qctr);
        block_sync();
        j = nbx + __builtin_amdgcn_readfirstlane((int)*(volatile LAS unsigned*)(lds + 135936));
    }
}
#endif


#define XB_TMO      128
#define XB_XCNT(j)  (256  + 64 * (j))
#define XB_XSUB(j)  (1280 + 64 * (j))
#define XB_XGEN(j)  (2304 + 64 * (j))
#define XB_TOP      3328
#define XB_TOPGEN   3392
#define XCD_BAR_WORDS 3456
#define XB_SPIN_CAP (1u << 20)
__device__ __forceinline__ unsigned xb_ld(unsigned* p)              { return __hip_atomic_load(p, __ATOMIC_RELAXED, __HIP_MEMORY_SCOPE_AGENT); }
__device__ __forceinline__ unsigned xb_add(unsigned* p, unsigned v) { return __hip_atomic_fetch_add(p, v, __ATOMIC_RELAXED, __HIP_MEMORY_SCOPE_AGENT); }
__device__ __forceinline__ unsigned xb_xcc_id() { return (unsigned)__builtin_amdgcn_s_getreg((3 << 11) | 20) & 0xFu; }
#define XB_SPIN(cond, bar) do { unsigned _sp = 0; while (cond) { __builtin_amdgcn_s_sleep(1); \
    if ((++_sp & 255u) == 0u) { if (xb_ld(&(bar)[XB_TMO])) break; if (_sp > XB_SPIN_CAP) { atomicAdd(&(bar)[XB_TMO], 1u); break; } } } } while (0)
struct XcdBarrier { unsigned* bar; unsigned x; volatile LAS unsigned* st; };
__device__ __forceinline__ XcdBarrier xcd_barrier_post(unsigned* bar, volatile LAS unsigned* st) {
    XcdBarrier b; b.bar = bar; b.x = xb_xcc_id(); b.st = st;
    if (opaque_tid() == 0) (void)xb_add(&bar[XB_XCNT(b.x)], 1u);
    return b;
}
__device__ __forceinline__ void xcd_barrier_complete(unsigned* bar, unsigned x, unsigned& nloc, unsigned& nx) {
    const unsigned G = gridDim.x * gridDim.y * gridDim.z;
    unsigned sum, cnt, mine, sp = 0u;
    for (;;) {
        sum = 0u; cnt = 0u; mine = 0u;
#pragma unroll
        for (unsigned j = 0; j < 16; ++j) { const unsigned c = xb_ld(&bar[XB_XCNT(j)]); sum += c; cnt += (c > 0u) ? 1u : 0u; mine = (j == x) ? c : mine; }
        if (sum == G) break;
        __builtin_amdgcn_s_sleep(1);
        if ((++sp & 255u) == 0u) { if (xb_ld(&bar[XB_TMO])) break; if (sp > XB_SPIN_CAP) { atomicAdd(&bar[XB_TMO], 1u); break; } }
    }
    nloc = mine > 0u ? mine : 1u; nx = cnt > 0u ? cnt : 1u;
}
__device__ __forceinline__ void xcd_barrier(const XcdBarrier& b) {
    asm volatile("s_waitcnt vmcnt(0)" ::: "memory");
    __syncthreads();
    if (opaque_tid() == 0) {
        unsigned* bar = b.bar;
        __builtin_amdgcn_s_waitcnt(0);
        unsigned nloc = b.st[0], nx = b.st[1];
        if (nloc == 0u) { xcd_barrier_complete(bar, b.x, nloc, nx); b.st[0] = nloc; b.st[1] = nx; }
        const unsigned old = xb_add(&bar[XB_XSUB(b.x)], 1u);
        const unsigned gen = old / nloc;
        if (old + 1u == (gen + 1u) * nloc) {
            __builtin_amdgcn_fence(__ATOMIC_RELEASE, "agent");
            asm volatile("s_waitcnt vmcnt(0)" ::: "memory");
            const unsigned og = xb_add(&bar[XB_TOP], 1u);
            const unsigned tg = og / nx;
            if (og + 1u == (tg + 1u) * nx) xb_add(&bar[XB_TOPGEN], 1u);
            else XB_SPIN(xb_ld(&bar[XB_TOPGEN]) == tg, bar);
            __builtin_amdgcn_fence(__ATOMIC_ACQUIRE, "agent");
            xb_add(&bar[XB_XGEN(b.x)], 1u);
            asm volatile("s_waitcnt vmcnt(0)" ::: "memory");
        } else {
            XB_SPIN(xb_ld(&bar[XB_XGEN(b.x)]) == gen, bar);
            __builtin_amdgcn_fence(__ATOMIC_ACQUIRE, "agent");
            asm volatile("s_waitcnt vmcnt(0)" ::: "memory");
        }
    }
    __syncthreads();
}

#define CG_SYNC() do { __builtin_amdgcn_fence(__ATOMIC_RELEASE, "agent"); grid.sync(); __builtin_amdgcn_fence(__ATOMIC_ACQUIRE, "agent"); } while (0)
#define GRID_SYNC() do { XcdBarrier xb_; xb_.bar = (unsigned*)(launder(p->ws) + WS_BAR); xb_.x = xb_xcc_id(); xb_.st = (volatile LAS unsigned*)(lds + 135168); xcd_barrier(xb_); } while (0)

__global__ void __launch_bounds__(512) mega(Params p_arg) {
    const KP p = (KP)__builtin_amdgcn_kernarg_segment_ptr();
    LAS unsigned char* lds = (LAS unsigned char*)lds_raw;
    { const int t0_ = threadIdx.x; if ((t0_ & 63) == 0) *(volatile LAS int*)(lds + TID_TAB_OFF + hw_slot() * 4) = t0_ >> 6; asm volatile("s_waitcnt lgkmcnt(0)" ::: "memory"); }
    cg::grid_group grid = cg::this_grid();
    unsigned char* ws = p->ws;
    const int G = gridDim.x, c = blockIdx.x;

#ifndef REP_PREP
#define REP_PREP 1
#endif
    unsigned* barw = (unsigned*)(ws + WS_BAR);
    volatile LAS unsigned* xst = (volatile LAS unsigned*)(lds + 135168);
    { const int t_ = opaque_tid(); if (t_ < 2) xst[t_] = 0u; }
    __syncthreads();
    (void)xcd_barrier_post(barw, xst);
    if (ws == nullptr) CG_SYNC();
    for (int rep = 0; rep < REP_PREP; ++rep) prep_phase(p, lds);
    GRID_SYNC();
    {
        if (c == G - 1) { const int t = opaque_tid(); const float* bp = (const float*)(ws + WS_B1P) + (size_t)(t >> 7) * 1024 + (t & 127); float s = 0.f;
#pragma unroll
            for (int q = 0; q < 8; ++q) s += bp[q * 128];
            ((float*)(ws + WS_BIAS1))[t] = s; }
        SchedFold S{(const char*)(ws + WS_WGRPT), (const char*)(ws + WS_WCXN), G, c};
        EpiFold E{ws};
#ifndef NO_FOLD
        pg8::gemm_phase(lds, 512, 512, 2048, S, E);
#endif
        rms_mod_phase(p->in[I_X], p->in[I_NORMG], (const float*)(ws + WS_MOD), (bf16_t*)(ws + WS_H));
    }
    GRID_SYNC();
    for (int layer = 0; layer < 2; ++layer) {
        {
            SchedStd S{(const char*)(ws + WS_H), (const char*)(ws + WS_WINT) + (size_t)layer * NPAD * 2048 * 2, 2048, 2048, 64, 92, 1, 0, 0, G, c};
            EpiMain E{ws, layer};
#ifndef REP_MAIN
#define REP_MAIN 1
#endif
            for (int rep = 0; rep < REP_MAIN; ++rep) pg8::gemm_phase(lds, 2048, 2048, 2048, S, E);
        }
        GRID_SYNC();
        {
#if EN_B
            SchedL3a S{(const char*)(ws + WS_KV), (const char*)(ws + WS_W1T) + (size_t)layer * 2 * 256 * 2048 * 2, (const char*)(ws + WS_H),
                       (const char*)(ws + WS_WINT) + ((size_t)layer * NPAD + 23552) * 2048 * 2, G, c};
            EpiCmp E{ws};
            pg8::gemm_phase(lds, 2048, 2048, 2048, S, E);
            if (c < 32) {
                __builtin_amdgcn_fence(__ATOMIC_ACQUIRE, "agent");
                kcvc_item(p, layer, 2 * (c & 15), c >> 4); kcvc_item(p, layer, 2 * (c & 15) + 1, c >> 4);
            }
#endif
#if EN_A
            if (G == 256) {
                if (c >= 96) { for (int k = 0; k < 5; ++k) amix_item(p, layer, lds, (c - 96) + 160 * k); }
                else if (c < 32) amix_item(p, layer, lds, 800 + c);
                else { for (int k = 0; k < 3; ++k) amix_item(p, layer, lds, 832 + (c - 32) + 64 * k); }
            } else for (int it = G - 1 - c; it < 1024; it += G) amix_item(p, layer, lds, it);
#endif
#if EN_C
            for (int it = c; it < 512; it += G) cpool_item(p, layer, it);
#endif
        }
        GRID_SYNC();
#if EN_B
#ifndef REP_ATT
#define REP_ATT 1
#endif
        for (int rep = 0; rep < REP_ATT; ++rep) attn_phase(p, layer, lds);
        GRID_SYNC();
#endif
        {
            SchedBranch S{(const char*)(ws + WS_U), (const char*)(ws + WS_XW), (const char*)(ws + WS_SGC), (const char*)(ws + WS_WBRT) + (size_t)layer * 3 * 2048 * 2048 * 2, G, c};
            EpiBranch E{ws};
#ifndef REP_BR
#define REP_BR 1
#endif
            for (int rep = 0; rep < REP_BR; ++rep) pg8::gemm_phase(lds, 2048, 2048, 2048, S, E);
        }
        GRID_SYNC();
        {
            SchedStd S{(const char*)(ws + WS_V), (const char*)(ws + WS_WOUTT) + (size_t)layer * 2048 * 2048 * 2, 2048, 2048, 64, 8, 1, 0, 0, G, c};
            EpiOut E{layer == 0 ? p->in[I_X] : (const float*)(ws + WS_XRES), layer == 0 ? (float*)(ws + WS_XRES) : p->out, (const float*)(ws + WS_MOD) + (size_t)layer * 8 * 6144 + 4096};
#ifndef REP_OUT
#define REP_OUT 1
#endif
            for (int rep = 0; rep < REP_OUT; ++rep) pg8::gemm_phase(lds, 2048, 2048, 2048, S, E);
        }
        GRID_SYNC();
        if (layer == 0) {
            rms_mod_phase((const float*)(ws + WS_XRES), p->in[I_NORMG] + 2048, (const float*)(ws + WS_MOD) + 8 * 6144, (bf16_t*)(ws + WS_H));
            GRID_SYNC();
        }
    }
#ifdef EXTRA_SYNCS
    for (int q = 0; q < EXTRA_SYNCS; ++q) GRID_SYNC();
#endif
    final_rms_phase(p->out, p->in[I_FINALG]);
}

extern "C" void kernel_launch(void* const* d_in, const int* in_sizes, int n_in, void* d_out, int out_size, void* d_ws, size_t ws_size, hipStream_t stream) {
    static int grid_blocks = 0;
    if (!grid_blocks) {
        int dev = 0, cus = 0, per_cu = 0;
        (void)hipGetDevice(&dev);
        (void)hipDeviceGetAttribute(&cus, hipDeviceAttributeMultiprocessorCount, dev);
        (void)hipFuncSetAttribute((const void*)mega, hipFuncAttributeMaxDynamicSharedMemorySize, LDS_BYTES);
        (void)hipOccupancyMaxActiveBlocksPerMultiprocessor(&per_cu, (const void*)mega, 512, LDS_BYTES);
        if (per_cu < 1) per_cu = 1;
        grid_blocks = cus * per_cu;
        if (ws_size < WS_END) fprintf(stderr, "workspace too small: %zu < %zu\n", ws_size, (size_t)WS_END);
    }
    Params p{};
    for (int i = 0; i < 19; ++i) p.in[i] = (const float*)d_in[i];
    p.out = (float*)d_out; p.ws = (unsigned char*)d_ws;
    (void)hipMemsetAsync((unsigned char*)d_ws + WS_BAR, 0, 16384, stream);
    void* args[] = {&p};
    hipError_t e = hipLaunchCooperativeKernel((void*)mega, dim3(grid_blocks), dim3(512), args, LDS_BYTES, stream);
    if (e != hipSuccess) fprintf(stderr, "cooperative launch failed: %s (grid %d)\n", hipGetErrorString(e), grid_blocks);
}
```

```cpp
#include <hip/hip_runtime.h>
#include <hip/hip_cooperative_groups.h>
#include <cstdio>
#include <cstdint>
namespace cg = cooperative_groups;

#ifndef EN_A
#define EN_A 1
#endif
#ifndef EN_B
#define EN_B 1
#endif
#ifndef EN_C
#define EN_C 1
#endif

#define LAS __attribute__((address_space(3)))
typedef unsigned short bf16_t;
typedef short bf16x8 __attribute__((ext_vector_type(8)));
typedef float f32x4 __attribute__((ext_vector_type(4)));
typedef float f32x16 __attribute__((ext_vector_type(16)));
typedef unsigned u32x4 __attribute__((ext_vector_type(4)));
typedef unsigned u32x2 __attribute__((ext_vector_type(2)));

constexpr int D = 2048, SEQ = 2048, NB = 8, NTOK = NB * SEQ;
constexpr int NCOLS = 23600;
constexpr int NPAD = 23808;
constexpr int LDS_BYTES = 136 * 1024;
constexpr float LOG2E = 1.4426950408889634f;

constexpr size_t SZ_ACT = (size_t)NTOK * 2048 * 2;
constexpr size_t WS_WINT = 0;
constexpr size_t WS_WCXN = WS_WINT + (size_t)2 * NPAD * 2048 * 2;
constexpr size_t WS_WBRT = WS_WCXN + (size_t)2 * 2048 * 2048 * 2;
constexpr size_t WS_WOUTT = WS_WBRT + (size_t)6 * 2048 * 2048 * 2;
constexpr size_t WS_WGRPT = WS_WOUTT + (size_t)2 * 2048 * 2048 * 2;
constexpr size_t WS_WSM = WS_WGRPT + (size_t)8 * 512 * 512 * 2;
constexpr size_t WS_W1T = WS_WSM + (size_t)16 * 128 * 128 * 2;
constexpr size_t WS_W2T = WS_W1T + (size_t)4 * 256 * 2048 * 2;
constexpr size_t WS_BIAS1 = WS_W2T + (size_t)4 * 128 * 128 * 2;
constexpr size_t WS_MOD = WS_BIAS1 + 4096;
constexpr size_t WS_STATS = WS_MOD + (size_t)2 * 8 * 6144 * 4;
constexpr size_t WS_GS = WS_STATS + (size_t)2 * NTOK * 2 * 4;
constexpr size_t WS_PQ = WS_GS + (size_t)NTOK * 48 * 4;
constexpr size_t WS_H = WS_PQ + (size_t)2 * 4096 * 256 * 4 + 65536;
constexpr size_t WS_U = WS_H + SZ_ACT;
constexpr size_t WS_V = WS_U + SZ_ACT;
constexpr size_t WS_SG = WS_V + SZ_ACT;
constexpr size_t WS_Q = WS_SG + SZ_ACT;
constexpr size_t WS_SGB = WS_Q + SZ_ACT;
constexpr size_t WS_XW = WS_SGB + SZ_ACT;
constexpr size_t WS_SGC = WS_XW + SZ_ACT;
constexpr size_t WS_KV = WS_SGC + SZ_ACT;
constexpr size_t KV_SLAB = (size_t)NTOK * 512;
constexpr size_t WS_MG = WS_KV + 6 * KV_SLAB * 2 + (1 << 20);
constexpr size_t WS_XRES = WS_MG + (size_t)NTOK * 6144 * 2;
constexpr size_t WS_STATP = WS_XRES + (size_t)NTOK * 2048 * 4;
constexpr size_t WS_B1P = WS_STATP + (size_t)32 * NTOK * 2 * 4;
constexpr size_t WS_BAR = WS_B1P + 16384;
constexpr size_t WS_KCI = WS_BAR + 16384;
constexpr size_t WS_END = WS_KCI + (size_t)64 * 32768;

struct Params {
    const float* in[19];
    float* out;
    unsigned char* ws;
};
typedef const __attribute__((address_space(4))) Params* KP;
enum { I_X = 0, I_C, I_RELB, I_NORMG, I_WADA, I_BADA, I_WIN, I_ALNG, I_ALNB, I_AWS, I_ABS, I_WCMP1, I_WCMP2, I_POSCMP, I_CWGRP, I_CSCALE, I_WBR, I_WOUT, I_FINALG };

typedef float f32x2_t __attribute__((ext_vector_type(2)));
typedef __bf16 bf16x2_t __attribute__((ext_vector_type(2)));
__device__ __forceinline__ unsigned cvt_pk_bf16(float lo, float hi) { const f32x2_t v = {lo, hi}; return __builtin_bit_cast(unsigned, __builtin_convertvector(v, bf16x2_t)); }
__device__ __forceinline__ float bf_lo(unsigned w) { return __uint_as_float(w << 16); }
__device__ __forceinline__ float bf_hi(unsigned w) { return __uint_as_float(w & 0xffff0000u); }
__device__ __forceinline__ float sigmoid_f(float x) { return __builtin_amdgcn_rcpf(1.f + __expf(-x)); }
__device__ __forceinline__ float silu_f(float x) { return x * sigmoid_f(x); }
__device__ __forceinline__ float gelu_f(float x) { const float u = 1.5957691216057308f * (x + 0.044715f * x * x * x); return x * sigmoid_f(u); }
__device__ __forceinline__ float shfl_xor_l(float v, int o, int lane) { return __builtin_bit_cast(float, __builtin_amdgcn_ds_bpermute(((lane ^ o) & 63) << 2, __builtin_bit_cast(int, v))); }
__device__ __forceinline__ float wave_sum(float v, int lane) {
#pragma unroll
    for (int o = 1; o < 64; o <<= 1) v += shfl_xor_l(v, o, lane);
    return v;
}
template <class T> __device__ __forceinline__ T* launder(T* p) { size_t z = 0; asm volatile("" : "+s"(z)); return (T*)((unsigned char*)p + z); }
extern __shared__ __attribute__((aligned(16))) unsigned char lds_raw[];
constexpr int TID_TAB_OFF = 135424;
__device__ __forceinline__ int hw_slot() { return (int)(__builtin_amdgcn_s_getreg((5 << 11) | 4) & 63u); }
__device__ __forceinline__ int opaque_tid() {
    unsigned z = 0u; asm volatile("" : "+v"(z));
    const int lane = (int)__builtin_amdgcn_mbcnt_hi(~0u, __builtin_amdgcn_mbcnt_lo(~0u, z));
    const int w = *(volatile LAS int*)((LAS unsigned char*)lds_raw + TID_TAB_OFF + hw_slot() * 4);
    int t = (w << 6) | lane; asm volatile("" : "+v"(t)); return t;
}
#define WAIT_VM0() asm volatile("s_waitcnt vmcnt(0)" ::: "memory")
#define WAIT_LGKM0() asm volatile("s_waitcnt lgkmcnt(0)" ::: "memory")
__device__ __forceinline__ void block_sync() { asm volatile("s_waitcnt vmcnt(0) lgkmcnt(0)" ::: "memory"); __builtin_amdgcn_s_barrier(); asm volatile("" ::: "memory"); }

namespace pg8 {
constexpr int BM = 256, BK = 64, HALF = 128, HTB = HALF * BK * 2, NXCD = 8, WGM = 8;
__device__ __forceinline__ int lds_byte(int r, int c) { const int st = (r >> 4) * 2 + (c >> 5), rr = r & 15, cc = c & 31, ob = rr * 64 + cc * 2; return st * 1024 + (ob ^ (((ob >> 9) & 1) << 5)); }
__device__ __forceinline__ void stage_rc(int b, int& R, int& C) { const int st = b / 1024, sb = b % 1024, swz = sb ^ (((sb >> 9) & 1) << 5); R = (st >> 1) * 16 + swz / 64; C = (st & 1) * 32 + (swz % 64) / 2; }
__device__ __forceinline__ int perm32(int rho) { const int n = rho >> 4, i = rho & 15; return 8 * (i >> 2) + 4 * n + (i & 3); }
struct Unit { int pm, pn, z; };
__device__ __forceinline__ void tile_swizzle(int wgid, int nM, int nN, int& pm, int& pn) {
    const int nwg = nM * nN;
    { const int q = nwg / NXCD, r = nwg % NXCD, xcd = wgid % NXCD, off = wgid / NXCD; wgid = (xcd < r ? xcd * (q + 1) : r * (q + 1) + (xcd - r) * q) + off; }
    const int nig = WGM * nN, gid = wgid / nig, fm = gid * WGM, gsz = (nM - fm) < WGM ? (nM - fm) : WGM;
    pm = fm + ((wgid % nig) % gsz); pn = (wgid % nig) / gsz;
}
template <class Sched, class Epi>
__device__ __forceinline__ void gemm_phase(LAS unsigned char* lds, const int K, const int lda, const int ldb, const Sched& S, const Epi& E) {
    const int tid = opaque_tid(), wid = __builtin_amdgcn_readfirstlane(tid >> 6), lane = tid & 63, wr = wid >> 2, wc = wid & 3, fr = lane & 15, fq = lane >> 4;
    const int nt = K / BK;
    unsigned voffA[2], voffB[2];
#pragma unroll
    for (int i = 0; i < 2; ++i) { int R, C; stage_rc(tid * 16 + i * 8192, R, C); const int Rb = (R & ~31) + perm32(R & 31);
        voffA[i] = (unsigned)(R * lda + C) * 2u; voffB[i] = (unsigned)(Rb * ldb + C) * 2u; }
    const size_t kstep = (size_t)(BK * 2);
    const size_t hstepA = (size_t)HALF * lda * 2, hstepB = (size_t)HALF * ldb * 2;
    const unsigned ldsw = (unsigned)wid * 1024u;
    const int aoff = lds_byte(wr * 64 + fr, fq * 8), boff = lds_byte(wc * 32 + fr, fq * 8);
#define PG8_SA(b, h) (((b) * 2 + (h)) * HTB)
#define PG8_SB(b, h) ((4 + (b) * 2 + (h)) * HTB)
#define PG8_STAGE(bufoff, gbase, voff) do { _Pragma("unroll") for (int _i = 0; _i < 2; ++_i) \
        __builtin_amdgcn_global_load_lds((const unsigned*)((const char*)(gbase) + (voff)[_i]), (LAS unsigned*)(lds + (bufoff) + ldsw + _i * 8192), 16, 0, 0); } while (0)
#define PG8_LDA(dst, b, h) do { _Pragma("unroll") for (int m = 0; m < 4; ++m) _Pragma("unroll") for (int k = 0; k < 2; ++k) dst[m][k] = *(const LAS bf16x8*)(lds + PG8_SA(b, h) + aoff + m * 2048 + k * 1024); } while (0)
#define PG8_LDB(dst, b, h) do { _Pragma("unroll") for (int n = 0; n < 2; ++n) _Pragma("unroll") for (int k = 0; k < 2; ++k) dst[n][k] = *(const LAS bf16x8*)(lds + PG8_SB(b, h) + boff + n * 2048 + k * 1024); } while (0)
#define PG8_MMA(ai, bj, At, Bt) do { __builtin_amdgcn_s_setprio(1); _Pragma("unroll") for (int m = 0; m < 4; ++m) _Pragma("unroll") for (int n = 0; n < 2; ++n) _Pragma("unroll") for (int k = 0; k < 2; ++k) \
        acc[ai][bj][m][n] = __builtin_amdgcn_mfma_f32_16x16x32_bf16(Bt[n][k], At[m][k], acc[ai][bj][m][n], 0, 0, 0); __builtin_amdgcn_s_setprio(0); } while (0)
#define PG8_WAIT_V(n) asm volatile("s_waitcnt vmcnt(" #n ")" ::: "memory")
#define PG8_WAIT_L(n) asm volatile("s_waitcnt lgkmcnt(" #n ")" ::: "memory")
#define PG8_BAR __builtin_amdgcn_s_barrier()
#define PG8_SCHED __builtin_amdgcn_sched_barrier(0)
    Unit cur, nxt; int ui = 0;
    if (!S.next(0, cur)) return;
    f32x4 acc[2][2][4][2];
#pragma unroll
    for (int a = 0; a < 2; ++a)
#pragma unroll
        for (int b = 0; b < 2; ++b)
#pragma unroll
            for (int m = 0; m < 4; ++m)
#pragma unroll
                for (int n = 0; n < 2; ++n) acc[a][b][m][n] = (f32x4){0.f, 0.f, 0.f, 0.f};
    bf16x8 At[4][2], B0[2][2], B1[2][2];
    const char* cA = launder(S.abase(cur)); const char* cB = launder(S.bbase(cur));
    PG8_STAGE(PG8_SB(0, 0), cB, voffB); PG8_STAGE(PG8_SA(0, 0), cA, voffA); PG8_STAGE(PG8_SB(0, 1), cB + hstepB, voffB); PG8_STAGE(PG8_SA(0, 1), cA + hstepA, voffA);
    if (wr == 1) PG8_BAR;
    PG8_WAIT_V(4); PG8_BAR;
    PG8_STAGE(PG8_SB(1, 0), cB + kstep, voffB); PG8_STAGE(PG8_SA(1, 0), cA + kstep, voffA); PG8_STAGE(PG8_SB(1, 1), cB + hstepB + kstep, voffB);
    PG8_WAIT_V(6); PG8_BAR;
    for (;;) {
        const bool has_next = S.next(ui + 1, nxt);
        const char* nA = has_next ? launder(S.abase(nxt)) : cA; const char* nB = has_next ? launder(S.bbase(nxt)) : cB;
        for (int t = 0; t < nt; t += 2) {
            const bool last = (t == nt - 2);
            const char* a1 = cA + (size_t)(t + 1) * kstep;
            const char* a2 = last ? nA : cA + (size_t)(t + 2) * kstep; const char* b2 = last ? nB : cB + (size_t)(t + 2) * kstep;
            const char* a3 = a2 + kstep; const char* b3 = b2 + kstep;
            PG8_LDB(B0, 0, 0); PG8_SCHED; PG8_LDA(At, 0, 0); PG8_STAGE(PG8_SA(1, 1), a1 + hstepA, voffA);
            PG8_WAIT_L(8); PG8_BAR; PG8_WAIT_L(0); PG8_MMA(0, 0, At, B0); PG8_BAR; PG8_SCHED;
            PG8_LDB(B1, 0, 1); PG8_STAGE(PG8_SB(0, 0), b2, voffB);
            PG8_BAR; PG8_WAIT_L(0); PG8_MMA(0, 1, At, B1); PG8_BAR;
            PG8_LDA(At, 0, 1); PG8_STAGE(PG8_SA(0, 0), a2, voffA);
            PG8_BAR; PG8_WAIT_L(0); PG8_MMA(1, 0, At, B0); PG8_BAR; PG8_SCHED;
            PG8_STAGE(PG8_SB(0, 1), b2 + hstepB, voffB);
            PG8_WAIT_V(6); PG8_BAR; PG8_MMA(1, 1, At, B1); PG8_BAR;
            PG8_LDB(B0, 1, 0); PG8_SCHED; PG8_LDA(At, 1, 0); PG8_STAGE(PG8_SA(0, 1), a2 + hstepA, voffA);
            PG8_WAIT_L(8); PG8_BAR; PG8_WAIT_L(0); PG8_MMA(0, 0, At, B0); PG8_BAR; PG8_SCHED;
            PG8_LDB(B1, 1, 1); PG8_STAGE(PG8_SB(1, 0), b3, voffB);
            PG8_BAR; PG8_WAIT_L(0); PG8_MMA(0, 1, At, B1); PG8_BAR;
            PG8_LDA(At, 1, 1); PG8_STAGE(PG8_SA(1, 0), a3, voffA);
            PG8_BAR; PG8_WAIT_L(0); PG8_MMA(1, 0, At, B0); PG8_BAR; PG8_SCHED;
            PG8_STAGE(PG8_SB(1, 1), b3 + hstepB, voffB);
            PG8_WAIT_V(6); PG8_BAR; PG8_MMA(1, 1, At, B1); PG8_BAR;
        }
        E(acc, cur, wr, wc, fr, fq);
        if (!has_next) break;
#pragma unroll
        for (int a = 0; a < 2; ++a)
#pragma unroll
            for (int b = 0; b < 2; ++b)
#pragma unroll
                for (int m = 0; m < 4; ++m)
#pragma unroll
                    for (int n = 0; n < 2; ++n) acc[a][b][m][n] = (f32x4){0.f, 0.f, 0.f, 0.f};
        cur = nxt; cA = nA; cB = nB; ++ui;
    }
    PG8_WAIT_V(0);
    if (wr == 0) PG8_BAR;
    PG8_BAR;
#undef PG8_SA
#undef PG8_SB
#undef PG8_STAGE
#undef PG8_LDA
#undef PG8_LDB
#undef PG8_MMA
#undef PG8_WAIT_V
#undef PG8_WAIT_L
#undef PG8_BAR
#undef PG8_SCHED
}
}
using pg8::Unit;
typedef f32x4 AccT[2][2][4][2];

struct SchedStd {
    const char* A; const char* B; int lda, ldb, nM, nN, nZ; size_t zA, zB; int G, c;
    __device__ __forceinline__ bool next(int i, Unit& u) const {
        const long L = (long)i * G + c; const int per = nM * nN; if (L >= (long)per * nZ) return false;
        u.z = (int)(L / per); pg8::tile_swizzle((int)(L % per), nM, nN, u.pm, u.pn); return true; }
    __device__ __forceinline__ const char* abase(const Unit& u) const { return A + (size_t)u.z * zA + (size_t)u.pm * 256 * lda * 2; }
    __device__ __forceinline__ const char* bbase(const Unit& u) const { return B + (size_t)u.z * zB + (size_t)u.pn * 256 * ldb * 2; }
};
struct SchedFold {
    const char* A; const char* B; int G, c;
    __device__ __forceinline__ bool next(int i, Unit& u) const {
        const int L = i * G + c; if (L >= 128) return false; u.z = L >> 4; u.pm = (L >> 3) & 1; u.pn = L & 7; return true; }
    __device__ __forceinline__ const char* abase(const Unit& u) const { return A + (size_t)u.z * 512 * 512 * 2 + (size_t)u.pm * 256 * 512 * 2; }
    __device__ __forceinline__ const char* bbase(const Unit& u) const { return B + (size_t)(u.z >> 2) * 2048 * 2048 * 2 + (size_t)(u.z & 3) * 512 * 2 + (size_t)u.pn * 256 * 2048 * 2; }
};
struct SchedBranch {
    const char* A0; const char* A1; const char* A2; const char* B; int G, c;
    __device__ __forceinline__ bool next(int i, Unit& u) const {
        const int L = (i / 3) * G + c; if (L >= 512) return false; u.z = i % 3; pg8::tile_swizzle(L, 64, 8, u.pm, u.pn); return true; }
    __device__ __forceinline__ const char* abase(const Unit& u) const { const char* a = u.z == 0 ? A0 : (u.z == 1 ? A1 : A2); return a + (size_t)u.pm * 256 * 2048 * 2; }
    __device__ __forceinline__ const char* bbase(const Unit& u) const { return B + (size_t)u.z * 2048 * 2048 * 2 + (size_t)u.pn * 256 * 2048 * 2; }
};

struct SchedL3a {
    const char* KC; const char* W1; const char* H; const char* WG; int G, c;
    __device__ __forceinline__ bool next(int i, Unit& u) const {
        const int L = i * G + c; if (L >= 96) return false;
        if (L < 32) { u.z = L >> 4; u.pm = L & 15; u.pn = 0; } else { u.z = 2; u.pm = L - 32; u.pn = 0; }
        return true; }
    __device__ __forceinline__ const char* abase(const Unit& u) const { return (u.z == 2 ? H : KC + (size_t)u.z * 4096 * 2048 * 2) + (size_t)u.pm * 256 * 2048 * 2; }
    __device__ __forceinline__ const char* bbase(const Unit& u) const { return u.z == 2 ? WG : W1 + (size_t)u.z * 256 * 2048 * 2; }
};

#define EPI_ROW(ai, m) (u.pm * 256 + (ai) * 128 + wr * 64 + (m) * 16 + fr)
#define EPI_COLT(bj) ((bj) * 128 + wc * 32 + 8 * fq)
__device__ __forceinline__ u32x4 pack8(const f32x4 a, const f32x4 b) { u32x4 w; w.x = cvt_pk_bf16(a[0], a[1]); w.y = cvt_pk_bf16(a[2], a[3]); w.z = cvt_pk_bf16(b[0], b[1]); w.w = cvt_pk_bf16(b[2], b[3]); return w; }

struct EpiMain {
    unsigned char* ws0; int layer;
    __device__ __forceinline__ void operator()(const AccT& acc, const Unit& u, int wr, int wc, int fr, int fq) const {
        unsigned char* ws = launder(this->ws0);
        const int pn = u.pn;
        int act, store = 0, cb = 0, ldc = 2048; bf16_t* dst = nullptr; bool stats = false;
        if (pn < 8) { act = 0; dst = (bf16_t*)(ws + WS_U); cb = pn * 256; }
        else if (pn < 16) { act = 1; dst = (bf16_t*)(ws + WS_V); cb = (pn - 8) * 256; stats = true; }
        else if (pn < 24) { act = 0; dst = (bf16_t*)(ws + WS_SG); cb = (pn - 16) * 256; }
        else if (pn < 32) { act = 4; dst = (bf16_t*)(ws + WS_Q); cb = (pn - 24) * 256; }
        else if (pn < 44) { act = 0; const int j = (pn - 32) >> 1; store = (j < 2) ? 1 : ((j & 1) ? 2 : 4); dst = (bf16_t*)(ws + WS_KV) + (size_t)j * KV_SLAB; cb = ((pn - 32) & 1) * 2; }
        else if (pn < 52) { act = 0; dst = (bf16_t*)(ws + WS_SGB); cb = (pn - 44) * 256; }
        else if (pn < 60) { act = 0; dst = (bf16_t*)(ws + WS_XW); cb = (pn - 52) * 256; }
        else if (pn < 68) { act = 0; dst = (bf16_t*)(ws + WS_SGC); cb = (pn - 60) * 256; }
        else { act = 3; dst = (bf16_t*)(ws + WS_MG); cb = (pn - 68) * 256; ldc = 6144; }
        float* st = (float*)(ws + WS_STATP) + (size_t)(((pn - 8) & 7) * 4 + wc) * NTOK * 2;
#pragma unroll
        for (int ai = 0; ai < 2; ++ai)
#pragma unroll
            for (int m = 0; m < 4; ++m) {
                const int row = EPI_ROW(ai, m);
                float rs = 0.f, rq = 0.f;
#pragma unroll
                for (int bj = 0; bj < 2; ++bj) {
                    f32x4 v0 = acc[ai][bj][m][0], v1 = acc[ai][bj][m][1];
                    if (act == 1) {
#pragma unroll
                        for (int j = 0; j < 4; ++j) { v0[j] = gelu_f(v0[j]); v1[j] = gelu_f(v1[j]); }
                    } else if (act == 2) {
#pragma unroll
                        for (int j = 0; j < 4; ++j) { v0[j] = silu_f(v0[j]); v1[j] = silu_f(v1[j]); }
                    } else if (act == 3) {
#pragma unroll
                        for (int j = 0; j < 4; ++j) { v0[j] = sigmoid_f(v0[j]); v1[j] = sigmoid_f(v1[j]); }
                    } else if (act == 4) {
                        const float qs = 0.08838834764831845f * LOG2E;
                        v0 = v0 * qs; v1 = v1 * qs;
                    }
                    if (stats) {
#pragma unroll
                        for (int j = 0; j < 4; ++j) { rs += v0[j] + v1[j]; rq += v0[j] * v0[j] + v1[j] * v1[j]; }
                    }
                    const int colt = EPI_COLT(bj);
                    if (store == 0) {
                        __builtin_nontemporal_store(pack8(v0, v1), (u32x4*)(dst + (size_t)row * ldc + cb + colt));
                    } else if (store == 1) {
                        const int bb = row >> 11, t = row & 2047, g = cb + bj, d0 = wc * 32 + 8 * fq;
                        *(u32x4*)(dst + ((size_t)(bb * 4 + g) * 2048 + t) * 128 + d0) = pack8(v0, v1);
                    } else if (store == 4) {
                        const int bb = row >> 11, t = row & 2047, g = cb + bj, c = wc * 4 + fq;
                        *(u32x4*)(dst + ((((size_t)(bb * 4 + g) * 32 + (t >> 6)) * 16 + c) * 64 + (t & 63)) * 8) = pack8(v0, v1);
                    } else if (store == 2) {
                        const int bb = row >> 11, t = row & 2047, g = cb + bj, d0 = wc * 32 + 8 * fq;
                        bf16_t* pp = dst + ((((size_t)(bb * 4 + g) * 32 + (t >> 6)) * 8 + ((t & 63) >> 3)) * 128 + d0) * 8 + (t & 7);
                        const u32x4 w = pack8(v0, v1);
                        pp[0] = (bf16_t)(w.x & 0xffff); pp[8] = (bf16_t)(w.x >> 16); pp[16] = (bf16_t)(w.y & 0xffff); pp[24] = (bf16_t)(w.y >> 16);
                        pp[32] = (bf16_t)(w.z & 0xffff); pp[40] = (bf16_t)(w.z >> 16); pp[48] = (bf16_t)(w.w & 0xffff); pp[56] = (bf16_t)(w.w >> 16);
                    }
                }
                if (stats) {
                    { const int ln = fq * 16 + fr; rs += shfl_xor_l(rs, 16, ln); rs += shfl_xor_l(rs, 32, ln); rq += shfl_xor_l(rq, 16, ln); rq += shfl_xor_l(rq, 32, ln); }
                    if (fq == 0) { typedef float f32x2 __attribute__((ext_vector_type(2))); *(f32x2*)(st + (size_t)row * 2) = (f32x2){rs, rq}; }
                }
            }
    }
};
struct EpiFold {
    unsigned char* ws0;
    __device__ __forceinline__ void operator()(const AccT& acc, const Unit& u, int wr, int wc, int fr, int fq) const {
        unsigned char* ws = launder(ws0);
        const int l = u.z >> 2, gi = u.z & 3;
        bf16_t* dst = (bf16_t*)(ws + WS_WINT) + ((size_t)l * NPAD + 13312 + gi * 512) * 2048;
#pragma unroll
        for (int ai = 0; ai < 2; ++ai)
#pragma unroll
            for (int m = 0; m < 4; ++m)
#pragma unroll
                for (int bj = 0; bj < 2; ++bj)
                    *(u32x4*)(dst + (size_t)EPI_ROW(ai, m) * 2048 + u.pn * 256 + EPI_COLT(bj)) = pack8(acc[ai][bj][m][0], acc[ai][bj][m][1]);
    }
};
struct EpiCmp {
    unsigned char* ws0;
    __device__ __forceinline__ void operator()(const AccT& acc, const Unit& u, int wr, int wc, int fr, int fq) const {
        unsigned char* ws = launder(ws0);
        if (u.z < 2) {
            float* dst = (float*)(ws + WS_PQ) + (size_t)u.z * 4096 * 256;
#pragma unroll
            for (int ai = 0; ai < 2; ++ai)
#pragma unroll
                for (int m = 0; m < 4; ++m)
#pragma unroll
                    for (int bj = 0; bj < 2; ++bj) { float* pp = dst + (size_t)EPI_ROW(ai, m) * 256 + EPI_COLT(bj); *(f32x4*)pp = acc[ai][bj][m][0]; *(f32x4*)(pp + 4) = acc[ai][bj][m][1]; }
        } else {
            float* gs = (float*)(ws + WS_GS);
            const int colt = EPI_COLT(0);
            if (colt < 48) {
#pragma unroll
                for (int ai = 0; ai < 2; ++ai)
#pragma unroll
                    for (int m = 0; m < 4; ++m) { f32x4 v0 = acc[ai][0][m][0], v1 = acc[ai][0][m][1];
#pragma unroll
                        for (int j = 0; j < 4; ++j) { v0[j] = sigmoid_f(v0[j]); v1[j] = sigmoid_f(v1[j]); }
                        float* pp = gs + (size_t)EPI_ROW(ai, m) * 48 + colt; *(f32x4*)pp = v0; *(f32x4*)(pp + 4) = v1; }
            }
        }
    }
};
struct EpiBranch {
    unsigned char* ws0;
    __device__ __forceinline__ void operator()(const AccT& acc, const Unit& u, int wr, int wc, int fr, int fq) const {
        unsigned char* ws = launder(ws0);
        float* tmp = (float*)(ws + WS_H) + (size_t)blockIdx.x * 65536;
        const bf16_t* mg = (const bf16_t*)(ws + WS_MG);
        bf16_t* y = (bf16_t*)(ws + WS_V);
        const int x = u.z;
        if (x > 0) __builtin_amdgcn_fence(__ATOMIC_ACQUIRE, "agent");
#pragma unroll
        for (int ai = 0; ai < 2; ++ai)
#pragma unroll
            for (int mh = 0; mh < 2; ++mh) {
                u32x4 mw[2][2]; f32x4 t0[2][2], t1[2][2];
#pragma unroll
                for (int mm = 0; mm < 2; ++mm)
#pragma unroll
                    for (int bj = 0; bj < 2; ++bj) {
                        const int m = 2 * mh + mm, row = EPI_ROW(ai, m), rl = ai * 128 + wr * 64 + m * 16 + fr, colt = EPI_COLT(bj);
                        mw[mm][bj] = *(const u32x4*)(mg + (size_t)row * 6144 + x * 2048 + u.pn * 256 + colt);
                        if (x > 0) { const float* tp = tmp + rl * 256 + colt; t0[mm][bj] = *(const f32x4*)tp; t1[mm][bj] = *(const f32x4*)(tp + 4); }
                    }
#pragma unroll
                for (int mm = 0; mm < 2; ++mm)
#pragma unroll
                    for (int bj = 0; bj < 2; ++bj) {
                        const int m = 2 * mh + mm, row = EPI_ROW(ai, m), rl = ai * 128 + wr * 64 + m * 16 + fr, colt = EPI_COLT(bj);
                        const u32x4 w = mw[mm][bj];
                        f32x4 v0 = acc[ai][bj][m][0], v1 = acc[ai][bj][m][1];
                        v0[0] *= bf_lo(w.x); v0[1] *= bf_hi(w.x); v0[2] *= bf_lo(w.y); v0[3] *= bf_hi(w.y);
                        v1[0] *= bf_lo(w.z); v1[1] *= bf_hi(w.z); v1[2] *= bf_lo(w.w); v1[3] *= bf_hi(w.w);
                        if ((!EN_A && x == 0) || (!EN_B && x == 1) || (!EN_C && x == 2)) { v0 = v0 * 0.f; v1 = v1 * 0.f; }
                        float* tp = tmp + rl * 256 + colt;
                        if (x > 0) { v0 = v0 + t0[mm][bj]; v1 = v1 + t1[mm][bj]; }
                        if (x < 2) { *(f32x4*)tp = v0; *(f32x4*)(tp + 4) = v1; }
                        else *(u32x4*)(y + (size_t)row * 2048 + u.pn * 256 + colt) = pack8(v0, v1);
                    }
            }
    }
};
struct EpiOut {
    const float* xin0; float* xout0; const float* gate0;
    __device__ __forceinline__ void operator()(const AccT& acc, const Unit& u, int wr, int wc, int fr, int fq) const {
        const float* xin = launder(xin0); float* xout = launder(xout0); const float* gate = launder(gate0);
        const int bb = (u.pm * 256) >> 11;
        f32x4 g0[2], g1[2];
#pragma unroll
        for (int bj = 0; bj < 2; ++bj) { const int col = u.pn * 256 + EPI_COLT(bj); g0[bj] = *(const f32x4*)(gate + (size_t)bb * 6144 + col); g1[bj] = *(const f32x4*)(gate + (size_t)bb * 6144 + col + 4); }
#pragma unroll
        for (int ai = 0; ai < 2; ++ai)
            {
                constexpr int mh = 0;
                f32x4 x0[4][2], x1[4][2];
#pragma unroll
                for (int mm = 0; mm < 4; ++mm)
#pragma unroll
                    for (int bj = 0; bj < 2; ++bj) { const int row = EPI_ROW(ai, 2 * mh + mm), col = u.pn * 256 + EPI_COLT(bj);
                        x0[mm][bj] = *(const f32x4*)(xin + (size_t)row * 2048 + col); x1[mm][bj] = *(const f32x4*)(xin + (size_t)row * 2048 + col + 4); }
#pragma unroll
                for (int mm = 0; mm < 4; ++mm)
#pragma unroll
                    for (int bj = 0; bj < 2; ++bj) { const int m = 2 * mh + mm, row = EPI_ROW(ai, m), col = u.pn * 256 + EPI_COLT(bj);
                        *(f32x4*)(xout + (size_t)row * 2048 + col) = x0[mm][bj] + g0[bj] * acc[ai][bj][m][0];
                        *(f32x4*)(xout + (size_t)row * 2048 + col + 4) = x1[mm][bj] + g1[bj] * acc[ai][bj][m][1]; }
            }
    }
};

__device__ __forceinline__ void wave_transpose(const float* src, int lds_, int nvalid, bf16_t* dst, int ldd, int lane, LAS unsigned char* wl) {
    const bool ok = lane < nvalid;
    const float* s = src + lane;
#pragma unroll
    for (int half = 0; half < 2; ++half) {
        float v[32];
#pragma unroll
        for (int j = 0; j < 32; ++j) v[j] = ok ? s[(size_t)(half * 32 + j) * lds_] : 0.f;
#pragma unroll
        for (int c = 0; c < 4; ++c) {
            u32x4 o; o.x = cvt_pk_bf16(v[8 * c], v[8 * c + 1]); o.y = cvt_pk_bf16(v[8 * c + 2], v[8 * c + 3]); o.z = cvt_pk_bf16(v[8 * c + 4], v[8 * c + 5]); o.w = cvt_pk_bf16(v[8 * c + 6], v[8 * c + 7]);
            *(LAS u32x4*)(wl + lane * 144 + (half * 4 + c) * 16) = o;
        }
    }
    asm volatile("s_waitcnt lgkmcnt(0)" ::: "memory");
#pragma unroll
    for (int j = 0; j < 8; ++j) {
        const int n = (lane >> 3) + 8 * j, c = lane & 7;
        const u32x4 o = *(const LAS u32x4*)(wl + n * 144 + c * 16);
        *(u32x4*)(dst + (size_t)n * ldd + c * 8) = o;
    }
    asm volatile("s_waitcnt lgkmcnt(0)" ::: "memory");
}

__device__ __forceinline__ void prep_phase(const KP p, LAS unsigned char* lds) {
    unsigned char* ws = launder(p->ws);
    const int tid = opaque_tid(), lane = tid & 63;
    constexpr int N_MOD = 192, N_B1 = 32, N_WCX = 64, N_WSM = 16, NBLK = N_MOD + N_B1 + N_WCX + N_WSM;
    for (int it = blockIdx.x; it < NBLK; it += gridDim.x) {
        int r = it;
        if (r < N_MOD) {
            const int l = r / 96, c0 = (r % 96) * 64;
            LAS float* sc = (LAS float*)lds;
            LAS float* red = sc + 8 * 2048;
            for (int e = tid; e < 8 * 2048; e += 512) sc[e] = silu_f(p->in[I_C][e]);
            block_sync();
            const int c4 = (tid & 15) * 4, ks = tid >> 4;
            f32x4 a[8];
#pragma unroll
            for (int b = 0; b < 8; ++b) a[b] = (f32x4){0.f, 0.f, 0.f, 0.f};
            const float* w = p->in[I_WADA] + (size_t)l * 2048 * 6144 + c0 + c4;
#pragma unroll 8
            for (int k = ks * 64; k < ks * 64 + 64; ++k) { const f32x4 wv = *(const f32x4*)(w + (size_t)k * 6144);
#pragma unroll
                for (int b = 0; b < 8; ++b) a[b] = a[b] + wv * sc[b * 2048 + k]; }
#pragma unroll
            for (int b = 0; b < 8; ++b) *(LAS f32x4*)(red + (ks * 8 + b) * 64 + c4) = a[b];
            block_sync();
            { const int b = tid >> 6, col = tid & 63; float s = p->in[I_BADA][(size_t)l * 6144 + c0 + col];
#pragma unroll 8
              for (int k2 = 0; k2 < 32; ++k2) s += red[(k2 * 8 + b) * 64 + col];
              ((float*)(ws + WS_MOD))[((size_t)l * 8 + b) * 6144 + c0 + col] = s; }
            block_sync();
            continue;
        } r -= N_MOD;
        if (r < N_B1) {
            LAS float* red = (LAS float*)lds;
            const int mi = r >> 3, part = r & 7, e = tid & 127, ks = tid >> 7; float s = 0.f;
            const float* pos = p->in[I_POSCMP] + (size_t)mi * 4096; const float* w1 = p->in[I_WCMP1] + (size_t)mi * 4096 * 128;
#pragma unroll 16
            for (int k = part * 512 + ks * 128; k < part * 512 + ks * 128 + 128; ++k) s += pos[k] * w1[(size_t)k * 128 + e];
            red[tid] = s; block_sync();
            if (tid < 128) ((float*)(ws + WS_B1P))[r * 128 + tid] = (red[tid] + red[tid + 128]) + (red[tid + 256] + red[tid + 384]);
            block_sync();
            continue;
        } r -= N_B1;
        if (r < N_WCX) {
            const int l = r >> 5, k0 = (r & 31) * 64;
#pragma unroll 4
            for (int e = tid; e < 64 * 512; e += 512) { const int k = k0 + (e >> 9), c4 = (e & 511) * 4;
                const f32x4 v = *(const f32x4*)(p->in[I_WIN] + (size_t)l * 2048 * NCOLS + (size_t)k * NCOLS + 13360 + c4);
                u32x2 o; o.x = cvt_pk_bf16(v[0], v[1]); o.y = cvt_pk_bf16(v[2], v[3]);
                *(u32x2*)((bf16_t*)(ws + WS_WCXN) + (size_t)l * 2048 * 2048 + (size_t)k * 2048 + c4) = o; }
            continue;
        } r -= N_WCX;
        {
            const float* srcp = p->in[I_AWS] + (size_t)r * 16384; bf16_t* dst = (bf16_t*)(ws + WS_WSM) + (size_t)r * 16384;
            for (int e = tid; e < 8192; e += 512) { const int t = (2 * e) >> 7, s = (2 * e) & 127;
                const float a = s <= t ? srcp[2 * e] : 0.f, b = (s + 1) <= t ? srcp[2 * e + 1] : 0.f;
                *(unsigned*)(dst + 2 * e) = cvt_pk_bf16(a, b); }
        }
    }
    constexpr int T_WIN = 2 * 340 * 32, T_WBR = 6 * 1024, T_WOUT = 2 * 1024, T_WGRP = 8 * 64, T_W1 = 4 * 128, T_W2 = 4 * 4;
    constexpr int T_TOTAL = T_WIN + T_WBR + T_WOUT + T_WGRP + T_W1 + T_W2;
    const int gw = blockIdx.x * 8 + (tid >> 6), nw = gridDim.x * 8;
    LAS unsigned char* wl = lds + (tid >> 6) * 9216;
    for (int it0 = gw; it0 < T_TOTAL; it0 += nw) {
        int r = __builtin_amdgcn_readfirstlane(it0);
        if (r < T_WIN) {
            const int l = r / (340 * 32); r -= l * 340 * 32; const int kt = r / 340; int nt = r - kt * 340; if (nt >= 208) nt += 32;
            const int n0 = nt * 64; int srcc, nvalid = 64;
            if (n0 < 11264) srcc = n0; else if (n0 < 23552) srcc = n0 + 48; else if (n0 == 23552) { srcc = 11264; nvalid = 48; } else { srcc = 0; nvalid = 0; }
            wave_transpose(p->in[I_WIN] + (size_t)l * 2048 * NCOLS + (size_t)kt * 64 * NCOLS + srcc, NCOLS, nvalid, (bf16_t*)(ws + WS_WINT) + ((size_t)l * NPAD + n0) * 2048 + kt * 64, 2048, lane, wl);
            continue;
        } r -= T_WIN;
        if (r < T_WBR) { const int mi = r >> 10; r &= 1023; const int kt = r >> 5, nt = r & 31;
            wave_transpose(p->in[I_WBR] + (size_t)mi * 2048 * 2048 + (size_t)kt * 64 * 2048 + nt * 64, 2048, 64, (bf16_t*)(ws + WS_WBRT) + (size_t)mi * 2048 * 2048 + (size_t)nt * 64 * 2048 + kt * 64, 2048, lane, wl); continue; } r -= T_WBR;
        if (r < T_WOUT) { const int mi = r >> 10; r &= 1023; const int kt = r >> 5, nt = r & 31;
            wave_transpose(p->in[I_WOUT] + (size_t)mi * 2048 * 2048 + (size_t)kt * 64 * 2048 + nt * 64, 2048, 64, (bf16_t*)(ws + WS_WOUTT) + (size_t)mi * 2048 * 2048 + (size_t)nt * 64 * 2048 + kt * 64, 2048, lane, wl); continue; } r -= T_WOUT;
        if (r < T_WGRP) { const int mi = r >> 6; r &= 63; const int kt = r >> 3, nt = r & 7;
            wave_transpose(p->in[I_CWGRP] + (size_t)mi * 512 * 512 + (size_t)kt * 64 * 512 + nt * 64, 512, 64, (bf16_t*)(ws + WS_WGRPT) + (size_t)mi * 512 * 512 + (size_t)nt * 64 * 512 + kt * 64, 512, lane, wl); continue; } r -= T_WGRP;
        if (r < T_W1) { const int mi = r >> 7; r &= 127; const int hh = r >> 6, kt = (r >> 1) & 31, nt = r & 1;
            wave_transpose(p->in[I_WCMP1] + (size_t)mi * 4096 * 128 + (size_t)(hh * 2048 + kt * 64) * 128 + nt * 64, 128, 64, (bf16_t*)(ws + WS_W1T) + (size_t)mi * 256 * 2048 + (size_t)(hh * 128 + nt * 64) * 2048 + kt * 64, 2048, lane, wl); continue; } r -= T_W1;
        { const int mi = r >> 2, kt = (r >> 1) & 1, nt = r & 1;
            wave_transpose(p->in[I_WCMP2] + (size_t)mi * 128 * 128 + (size_t)kt * 64 * 128 + nt * 64, 128, 64, (bf16_t*)(ws + WS_W2T) + (size_t)mi * 128 * 128 + (size_t)nt * 64 * 128 + kt * 64, 128, lane, wl); }
    }
}

__device__ __forceinline__ void rms_mod_phase(const float* x0, const float* g0, const float* mod0  , bf16_t* h0) {
    const float* x = launder(x0); const float* g = launder(g0); const float* mod = launder(mod0); bf16_t* h = launder(h0);
    const int tid_ = opaque_tid(); const int lane = tid_ & 63, gw = blockIdx.x * 8 + (tid_ >> 6), nw = gridDim.x * 8;
    for (int chunk = gw; chunk < NTOK / 8; chunk += nw) {
        const int row0 = chunk * 8;
        const float* mb = mod + (size_t)(row0 >> 11) * 6144;
        f32x4 gs[8], sh[8];
#pragma unroll
        for (int j = 0; j < 8; ++j) { const int c = 4 * (lane + 64 * j); gs[j] = *(const f32x4*)(g + c) * (*(const f32x4*)(mb + 2048 + c) + 1.f); sh[j] = *(const f32x4*)(mb + c); }
        f32x4 v[8], vn[8];
        { const f32x4* xr = (const f32x4*)(x + (size_t)row0 * D);
#pragma unroll
          for (int j = 0; j < 8; ++j) v[j] = xr[lane + 64 * j]; }
#pragma unroll 1
        for (int rr = 0; rr < 8; ++rr) {
            const int row = row0 + rr;
            if (rr < 7) { const f32x4* xr = (const f32x4*)(x + (size_t)(row + 1) * D);
#pragma unroll
                for (int j = 0; j < 8; ++j) vn[j] = xr[lane + 64 * j]; }
            float s = 0.f;
#pragma unroll
            for (int j = 0; j < 8; ++j) s += v[j][0] * v[j][0] + v[j][1] * v[j][1] + v[j][2] * v[j][2] + v[j][3] * v[j][3];
            s = wave_sum(s, lane);
            const float r = rsqrtf(s * (1.f / D) + 1e-6f);
#pragma unroll
            for (int j = 0; j < 8; ++j) {
                const f32x4 o = (v[j] * r) * gs[j] + sh[j];
                u32x2 w; w.x = cvt_pk_bf16(o[0], o[1]); w.y = cvt_pk_bf16(o[2], o[3]);
                *(u32x2*)(h + (size_t)row * D + 4 * (lane + 64 * j)) = w;
            }
#pragma unroll
            for (int j = 0; j < 8; ++j) v[j] = vn[j];
        }
    }
}
__device__ __forceinline__ void final_rms_phase(float* xo0, const float* g0) {
    float* xo = launder(xo0); const float* g = launder(g0);
    const int tid_ = opaque_tid(); const int lane = tid_ & 63, gw = blockIdx.x * 8 + (tid_ >> 6), nw = gridDim.x * 8;
    f32x4 gg[8];
#pragma unroll
    for (int j = 0; j < 8; ++j) gg[j] = *(const f32x4*)(g + 4 * (lane + 64 * j));
    f32x4 v[8], vn[8];
    if (gw < NTOK) { const f32x4* xr = (const f32x4*)(xo + (size_t)gw * D);
#pragma unroll
        for (int j = 0; j < 8; ++j) v[j] = xr[lane + 64 * j]; }
    for (int row = gw; row < NTOK; row += nw) {
        const int nrow = row + nw;
        if (nrow < NTOK) { const f32x4* xn = (const f32x4*)(xo + (size_t)nrow * D);
#pragma unroll
            for (int j = 0; j < 8; ++j) vn[j] = xn[lane + 64 * j]; }
        f32x4* xr = (f32x4*)(xo + (size_t)row * D);
        float s = 0.f;
#pragma unroll
        for (int j = 0; j < 8; ++j) s += v[j][0] * v[j][0] + v[j][1] * v[j][1] + v[j][2] * v[j][2] + v[j][3] * v[j][3];
        s = wave_sum(s, lane);
        const float r = rsqrtf(s * (1.f / D) + 1e-6f);
#pragma unroll
        for (int j = 0; j < 8; ++j) xr[lane + 64 * j] = (v[j] * r) * gg[j];
#pragma unroll
        for (int j = 0; j < 8; ++j) v[j] = vn[j];
    }
}

__device__ __forceinline__ void amix_item(const KP p, int layer, LAS unsigned char* lds, int item, unsigned* qctr) {
    unsigned char* ws = launder(p->ws);
    const int tid = opaque_tid(), wave = tid >> 6, lane = tid & 63;
    unsigned qv = 0u;
    if (tid == 0) qv = __hip_atomic_fetch_add(qctr, 1u, __ATOMIC_RELAXED, __HIP_MEMORY_SCOPE_AGENT);
    const int g = item & 7, ch = (item >> 3) & 15, b = item >> 7;
    const int T0 = b * 2048 + ch * 128, c0 = g * 256;
    LAS unsigned char* VT = lds;
    LAS unsigned char* WS_ = lds + 65536;
    LAS float* MR = (LAS float*)(lds + 98304);
    const float* st = (const float*)(ws + WS_STATP);
    {
        typedef float f32x2v __attribute__((ext_vector_type(2)));
        LAS float* RED = (LAS float*)(lds + 99328);
        const int t = tid & 127, pg = tid >> 7;
        f32x2v pv[8];
#pragma unroll
        for (int k = 0; k < 8; ++k) pv[k] = *(const f32x2v*)(st + ((size_t)(pg * 8 + k) * NTOK + T0 + t) * 2);
        float s = 0.f, q = 0.f;
#pragma unroll
        for (int k = 0; k < 8; ++k) { s += pv[k][0]; q += pv[k][1]; }
        RED[(pg * 128 + t) * 2] = s; RED[(pg * 128 + t) * 2 + 1] = q;
    }
    { const bf16_t* wsm = (const bf16_t*)(ws + WS_WSM) + (size_t)(layer * 8 + g) * 16384;
#pragma unroll
      for (int i = 0; i < 4; ++i) { const int c = tid + 512 * i, row = c >> 4, chn = c & 15;
          *(LAS u32x4*)(WS_ + row * 256 + ((chn ^ (row & 15)) << 4)) = *(const u32x4*)(wsm + row * 128 + chn * 8); } }
    block_sync();
    if (tid == 0) *(volatile LAS unsigned*)(lds + 135936) = qv;
    if (tid < 128) { const LAS float* RED = (const LAS float*)(lds + 99328); float s = 0.f, q = 0.f;
#pragma unroll
        for (int k = 0; k < 4; ++k) { s += RED[(k * 128 + tid) * 2]; q += RED[(k * 128 + tid) * 2 + 1]; }
        const float mean = s * (1.f / 2048.f); const float var = fmaxf(q * (1.f / 2048.f) - mean * mean, 0.f);
        MR[tid * 2] = mean; MR[tid * 2 + 1] = rsqrtf(var + 1e-6f); }
    block_sync();
    { const bf16_t* V = (const bf16_t*)(ws + WS_V);
      const float* lng = p->in[I_ALNG] + (size_t)layer * 2048 + c0; const float* lnb = p->in[I_ALNB] + (size_t)layer * 2048 + c0;
#pragma unroll
      for (int i = 0; i < 4; ++i) {
          const int id = tid + 512 * i, cg8 = id & 31, tp = id >> 5;
          const u32x4 a = *(const u32x4*)(V + (size_t)(T0 + 2 * tp) * 2048 + c0 + cg8 * 8), bq = *(const u32x4*)(V + (size_t)(T0 + 2 * tp + 1) * 2048 + c0 + cg8 * 8);
          const float m0 = MR[4 * tp], r0 = MR[4 * tp + 1], m1 = MR[4 * tp + 2], r1 = MR[4 * tp + 3];
          const f32x4 g0 = *(const f32x4*)(lng + cg8 * 8), g1 = *(const f32x4*)(lng + cg8 * 8 + 4), b0 = *(const f32x4*)(lnb + cg8 * 8), b1 = *(const f32x4*)(lnb + cg8 * 8 + 4);
          const unsigned aw[4] = {a.x, a.y, a.z, a.w}, bw[4] = {bq.x, bq.y, bq.z, bq.w};
#pragma unroll
          for (int j = 0; j < 8; ++j) {
              const float gg = j < 4 ? g0[j & 3] : g1[j & 3], bb = j < 4 ? b0[j & 3] : b1[j & 3];
              const float x0 = (j & 1) ? bf_hi(aw[j >> 1]) : bf_lo(aw[j >> 1]), x1 = (j & 1) ? bf_hi(bw[j >> 1]) : bf_lo(bw[j >> 1]);
              const int c = cg8 * 8 + j;
              *(LAS unsigned*)(VT + c * 256 + (((tp >> 2) ^ ((c ^ (c >> 3)) & 15)) << 4) + (tp & 3) * 4) = cvt_pk_bf16((x0 - m0) * r0 * gg + bb, (x1 - m1) * r1 * gg + bb);
          }
      } }
    block_sync();
    f32x4 acc[2][8];
#pragma unroll
    for (int mi = 0; mi < 2; ++mi)
#pragma unroll
        for (int ni = 0; ni < 8; ++ni) acc[mi][ni] = (f32x4){0.f, 0.f, 0.f, 0.f};
    const int fr = lane & 15, fq = lane >> 4;
#pragma unroll
    for (int ks = 0; ks < 4; ++ks) {
        bf16x8 af[2];
#pragma unroll
        for (int mi = 0; mi < 2; ++mi) { const int c = wave * 32 + mi * 16 + fr; af[mi] = *(const LAS bf16x8*)(VT + c * 256 + (((4 * ks + fq) ^ ((c ^ (c >> 3)) & 15)) << 4)); }
#pragma unroll
        for (int ni = 0; ni < 8; ++ni) {
            if (ks <= (ni >> 1)) {
                const int t = ni * 16 + fr; const bf16x8 bfr = *(const LAS bf16x8*)(WS_ + t * 256 + (((4 * ks + fq) ^ (t & 15)) << 4));
#pragma unroll
                for (int mi = 0; mi < 2; ++mi) acc[mi][ni] = __builtin_amdgcn_mfma_f32_16x16x32_bf16(af[mi], bfr, acc[mi][ni], 0, 0, 0);
            }
        }
    }
    { bf16_t* U = (bf16_t*)(ws + WS_U); const bf16_t* SG = (const bf16_t*)(ws + WS_SG); const float* bs = p->in[I_ABS] + (size_t)(layer * 8 + g) * 128;
      u32x2 uu[8][2], sg[8][2]; float bsv[8];
#pragma unroll
      for (int ni = 0; ni < 8; ++ni) {
          const int t = ni * 16 + fr; bsv[ni] = bs[t];
#pragma unroll
          for (int mi = 0; mi < 2; ++mi) { const size_t off = (size_t)(T0 + t) * 2048 + c0 + wave * 32 + mi * 16 + 4 * fq; uu[ni][mi] = *(const u32x2*)(U + off); sg[ni][mi] = *(const u32x2*)(SG + off); }
      }
#pragma unroll
      for (int ni = 0; ni < 8; ++ni) {
          const int t = ni * 16 + fr;
#pragma unroll
          for (int mi = 0; mi < 2; ++mi) {
              const size_t off = (size_t)(T0 + t) * 2048 + c0 + wave * 32 + mi * 16 + 4 * fq;
              const f32x4 a = acc[mi][ni]; const u32x2 u2 = uu[ni][mi], s2 = sg[ni][mi]; const float bv = bsv[ni];
              u32x2 o; o.x = cvt_pk_bf16(gelu_f(bf_lo(u2.x)) * (a[0] + bv) * silu_f(bf_lo(s2.x)), gelu_f(bf_hi(u2.x)) * (a[1] + bv) * silu_f(bf_hi(s2.x)));
              o.y = cvt_pk_bf16(gelu_f(bf_lo(u2.y)) * (a[2] + bv) * silu_f(bf_lo(s2.y)), gelu_f(bf_hi(u2.y)) * (a[3] + bv) * silu_f(bf_hi(s2.y)));
              *(u32x2*)(U + off) = o;
          }
      } }
    block_sync();
}

template <int WSZ>
__device__ __forceinline__ void cpool_body(const bf16_t* XW, bf16_t* SGC, const f32x4 l0, const f32x4 l1, const int t0) {
    u32x4 xw[8 + WSZ - 1], gq[8];
#pragma unroll
    for (int j = 0; j < WSZ - 1; ++j) { const int u = t0 - (WSZ - 1) + j; xw[j] = u >= 0 ? *(const u32x4*)(XW + (size_t)u * 2048) : (u32x4){0u, 0u, 0u, 0u}; }
#pragma unroll
    for (int i = 0; i < 8; ++i) { xw[WSZ - 1 + i] = *(const u32x4*)(XW + (size_t)(t0 + i) * 2048); gq[i] = *(const u32x4*)(SGC + (size_t)(t0 + i) * 2048); }
    float sum[8];
#pragma unroll
    for (int j = 0; j < 8; ++j) sum[j] = 0.f;
#pragma unroll
    for (int j = 0; j < WSZ - 1; ++j) { const u32x4 w = xw[j];
        sum[0] += bf_lo(w.x); sum[1] += bf_hi(w.x); sum[2] += bf_lo(w.y); sum[3] += bf_hi(w.y); sum[4] += bf_lo(w.z); sum[5] += bf_hi(w.z); sum[6] += bf_lo(w.w); sum[7] += bf_hi(w.w); }
#pragma unroll
    for (int i = 0; i < 8; ++i) {
        const u32x4 w = xw[WSZ - 1 + i], g4 = gq[i], w2 = xw[i];
        const float xv[8] = {bf_lo(w.x), bf_hi(w.x), bf_lo(w.y), bf_hi(w.y), bf_lo(w.z), bf_hi(w.z), bf_lo(w.w), bf_hi(w.w)};
        const float gv[8] = {silu_f(bf_lo(g4.x)), silu_f(bf_hi(g4.x)), silu_f(bf_lo(g4.y)), silu_f(bf_hi(g4.y)), silu_f(bf_lo(g4.z)), silu_f(bf_hi(g4.z)), silu_f(bf_lo(g4.w)), silu_f(bf_hi(g4.w))};
        const float ov[8] = {bf_lo(w2.x), bf_hi(w2.x), bf_lo(w2.y), bf_hi(w2.y), bf_lo(w2.z), bf_hi(w2.z), bf_lo(w2.w), bf_hi(w2.w)};
        const float inv = 1.f / (float)min(t0 + i + 1, WSZ);
        float o[8];
#pragma unroll
        for (int j = 0; j < 8; ++j) { sum[j] += xv[j]; o[j] = (sum[j] * inv - xv[j]) * (j < 4 ? l0[j & 3] : l1[j & 3]) * gv[j]; sum[j] -= ov[j]; }
        u32x4 ow; ow.x = cvt_pk_bf16(o[0], o[1]); ow.y = cvt_pk_bf16(o[2], o[3]); ow.z = cvt_pk_bf16(o[4], o[5]); ow.w = cvt_pk_bf16(o[6], o[7]);
        *(u32x4*)(SGC + (size_t)(t0 + i) * 2048) = ow;
    }
}
__device__ __forceinline__ void cpool_item(const KP p, int layer, int item) {
    unsigned char* ws = launder(p->ws);
    const int tid_ = opaque_tid(); const int wave = tid_ >> 6, lane = tid_ & 63;
    const int gi = item & 3, tt = (item >> 2) & 15, b = item >> 6;
    const int c = gi * 512 + lane * 8;
    const bf16_t* XW = (const bf16_t*)(ws + WS_XW) + (size_t)b * 2048 * 2048 + c;
    bf16_t* SGC = (bf16_t*)(ws + WS_SGC) + (size_t)b * 2048 * 2048 + c;
    const float* ls = p->in[I_CSCALE] + (size_t)layer * 2048 + c;
    const f32x4 l0 = *(const f32x4*)ls, l1 = *(const f32x4*)(ls + 4);
    const int t0 = tt * 128 + wave * 16;
    for (int hf = 0; hf < 2; ++hf) {
        if (gi == 0) cpool_body<2>(XW, SGC, l0, l1, t0 + 8 * hf);
        else if (gi == 1) cpool_body<4>(XW, SGC, l0, l1, t0 + 8 * hf);
        else if (gi == 2) cpool_body<8>(XW, SGC, l0, l1, t0 + 8 * hf);
        else cpool_body<16>(XW, SGC, l0, l1, t0 + 8 * hf);
    }
}

#if EN_B
constexpr int A_KB = 0, A_VB = 32768, A_BT = 65536, A_IMPH = 67584, A_IMPF = 101376, A_SEL = 109824, A_UNI = 110080;
__device__ __forceinline__ int kperm(int r) { return (r & ~12) | ((r & 8) >> 1) | ((r & 4) << 1); }
__device__ __forceinline__ int t5_bucket(int n) { if (n < 16) return n; const int v = 16 + (int)(logf((float)n * (1.f / 16.f)) / 2.0794415416798357f * 16.f); return v < 31 ? v : 31; }
__device__ __forceinline__ bf16x8 pack_frag(const f32x16& v, int s2) {
    u32x4 w; w.x = cvt_pk_bf16(v[8 * s2 + 0], v[8 * s2 + 1]); w.y = cvt_pk_bf16(v[8 * s2 + 2], v[8 * s2 + 3]); w.z = cvt_pk_bf16(v[8 * s2 + 4], v[8 * s2 + 5]); w.w = cvt_pk_bf16(v[8 * s2 + 6], v[8 * s2 + 7]);
    return __builtin_bit_cast(bf16x8, w);
}
#define ZERO16 ((f32x16){0.f,0.f,0.f,0.f,0.f,0.f,0.f,0.f,0.f,0.f,0.f,0.f,0.f,0.f,0.f,0.f})

__device__ __forceinline__ void kcvc_item(const KP p, const int layer, const int bg, const int isel) {
    unsigned char* ws = launder(p->ws);
    const int tid = opaque_tid(), wave = __builtin_amdgcn_readfirstlane(tid >> 6), lane = tid & 63, r = lane & 31, h = lane >> 5;
    unsigned char* img = ws + WS_KCI + (size_t)bg * 32768;
    {
        const int nb = wave & 3, dh = wave >> 2;
        {
            const int n = nb * 32 + r;
            const float nmask = n < 127 ? 1.f : 0.f;
#pragma unroll
            for (int i = 0; i < 2; ++i) {
                if (i != isel) continue;
                const float* Pr = (const float*)(ws + WS_PQ) + (size_t)i * 4096 * 256 + (size_t)(bg * 128 + n) * 256;
                const float* b1 = (const float*)(ws + WS_BIAS1) + (layer * 2 + i) * 128;
                const bf16_t* w2 = (const bf16_t*)(ws + WS_W2T) + (size_t)(layer * 2 + i) * 16384;
                f32x16 a0 = ZERO16, a1 = ZERO16;
#pragma unroll
                for (int ks = 0; ks < 8; ++ks) {
                    const int e0 = 16 * ks + 8 * h;
                    const f32x4 pa = *(const f32x4*)(Pr + e0), pb = *(const f32x4*)(Pr + e0 + 4), qa = *(const f32x4*)(Pr + 384 + e0), qb = *(const f32x4*)(Pr + 384 + e0 + 4);
                    const f32x4 ba = *(const f32x4*)(b1 + e0), bb = *(const f32x4*)(b1 + e0 + 4);
                    f32x4 x0 = pa + qa + ba, x1 = pb + qb + bb;
#pragma unroll
                    for (int j = 0; j < 4; ++j) { x0[j] = gelu_f(x0[j]) * nmask; x1[j] = gelu_f(x1[j]) * nmask; }
                    const bf16x8 hf = __builtin_bit_cast(bf16x8, pack8(x0, x1));
                    const bf16x8 w0 = *(const bf16x8*)(w2 + (size_t)(dh * 64 + r) * 128 + e0), w1 = *(const bf16x8*)(w2 + (size_t)(dh * 64 + 32 + r) * 128 + e0);
                    if (i == 0) { a0 = __builtin_amdgcn_mfma_f32_32x32x16_bf16(w0, hf, a0, 0, 0, 0); a1 = __builtin_amdgcn_mfma_f32_32x32x16_bf16(w1, hf, a1, 0, 0, 0); }
                    else { a0 = __builtin_amdgcn_mfma_f32_32x32x16_bf16(hf, w0, a0, 0, 0, 0); a1 = __builtin_amdgcn_mfma_f32_32x32x16_bf16(hf, w1, a1, 0, 0, 0); }
                }
#pragma unroll
                for (int dbl = 0; dbl < 2; ++dbl) {
                    const f32x16& a = dbl ? a1 : a0;
#pragma unroll
                    for (int aa = 0; aa < 4; ++aa) {
                        u32x2 w; w.x = cvt_pk_bf16(a[4 * aa], a[4 * aa + 1]); w.y = cvt_pk_bf16(a[4 * aa + 2], a[4 * aa + 3]);
                        if (i == 0) { const int chunk = dh * 8 + dbl * 4 + aa; *(u32x2*)(img + chunk * 2048 + n * 16 + 8 * h) = w; }
                        else { const int d = dh * 64 + dbl * 32 + r, chunk = nb * 4 + aa; *(u32x2*)(img + 32 * 32768 + chunk * 2048 + d * 16 + 8 * h) = w; }
                    }
                }
            }
        }
    }
}
__device__ __forceinline__ void attn_item(const KP p, const int layer, LAS unsigned char* lds, const int b, const int g, const int qi, unsigned* qctr) {
    unsigned char* ws = launder(p->ws);
    const int tid = opaque_tid(), wave = __builtin_amdgcn_readfirstlane(tid >> 6), lane = tid & 63, r = lane & 31, h = lane >> 5;
    const int hl = wave >> 1, head = g * 4 + hl, qh = wave & 1;
    const int t0 = qi * 64, ql = qh * 32 + r, tq = t0 + ql, bg = b * 4 + g;
    const size_t tok = (size_t)b * 2048 + tq;
    LAS float* BT = (LAS float*)(lds + A_BT);
    LAS float* IMPH = (LAS float*)(lds + A_IMPH);
    LAS float* IMPF = (LAS float*)(lds + A_IMPF);
    LAS unsigned* SEL = (LAS unsigned*)(lds + A_SEL);
    LAS unsigned* UNI = (LAS unsigned*)(lds + A_UNI);
#if defined(ATT_NO_CMP) || defined(ATT_NO_SEL)
    const bool dosel = false;
#else
    const bool dosel = qi >= 16;
#endif
    for (int e = tid; e < 4 * 64 * 33; e += 512) IMPH[e] = 0.f;
    if (tid < 64) SEL[tid] = dosel ? 0u : 0xffffffffu;
    if (tid == 64) UNI[0] = dosel ? 0u : 0xffffffffu;
    { const int hh = tid >> 7, dist = tid & 127; BT[tid] = p->in[I_RELB][t5_bucket(dist) * 16 + g * 4 + hh] * LOG2E; }
    bf16x8 qf[8];
    { const bf16_t* Qp = (const bf16_t*)(ws + WS_Q) + tok * 2048 + head * 128 + h * 8;
#pragma unroll
      for (int kk = 0; kk < 8; ++kk) qf[kk] = *(const bf16x8*)(Qp + kk * 16); }
    unsigned qv = 0u;
    if (tid == 0) qv = __hip_atomic_fetch_add(qctr, 1u, __ATOMIC_RELAXED, __HIP_MEMORY_SCOPE_AGENT);
#ifdef ATT_NO_CMP
    const int nblk = 0;
#else
    const int nblk = min(4, (4 * qi + 3 + 31) >> 5);
#endif
    { const bf16_t* kci = (const bf16_t*)(ws + WS_KCI) + (size_t)bg * 16384 + wave * 2048 + lane * 8;
#pragma unroll
      for (int i_ = 0; i_ < 4; ++i_) __builtin_amdgcn_global_load_lds((const unsigned*)(kci + i_ * 512), (LAS unsigned*)(lds + A_KB + (wave * 4 + i_) * 1024), 16, 0, 0);
#pragma unroll
      for (int i_ = 0; i_ < 4; ++i_) __builtin_amdgcn_global_load_lds((const unsigned*)(kci + (size_t)32 * 16384 + i_ * 512), (LAS unsigned*)(lds + A_VB + (wave * 4 + i_) * 1024), 16, 0, 0); }
    block_sync();
    if (tid == 0) *(volatile LAS unsigned*)(lds + 135936) = qv;
    const LAS float* BTh = BT + hl * 128;
    const int kcbase = kperm(r) * 16 + h * 2048, vbase = r * 16 + h * 2048, ktbase = kperm(r) * 16 + h * 1024;
    unsigned ofp[4][8];
    f32x16 oacc[4];
    {
        f32x16 sc[4];
        float mx = -1e30f;
#pragma unroll
        for (int kb = 0; kb < 4; ++kb) {
            sc[kb] = ZERO16;
            if (kb < nblk) {
#pragma unroll
                for (int kk = 0; kk < 8; ++kk) { const bf16x8 a = *(const LAS bf16x8*)(lds + A_KB + kcbase + kb * 512 + kk * 4096); sc[kb] = __builtin_amdgcn_mfma_f32_32x32x16_bf16(a, qf[kk], sc[kb], 0, 0, 0); }
                float bias[16];
#pragma unroll
                for (int i = 0; i < 16; ++i) { const int n = 32 * kb + 16 * (i >> 3) + 8 * h + (i & 7); const int dist = tq - (16 * n + 31); bias[i] = BTh[min(max(dist, 0), 127)]; }
#pragma unroll
                for (int i = 0; i < 16; ++i) asm volatile("" : "+v"(bias[i]));
#pragma unroll
                for (int i = 0; i < 16; ++i) {
                    const int n = 32 * kb + 16 * (i >> 3) + 8 * h + (i & 7);
                    const int dist = tq - (16 * n + 31);
                    const float s = dist >= 0 ? sc[kb][i] + bias[i] : -1e30f;
                    sc[kb][i] = s; mx = fmaxf(mx, s);
                }
            }
        }
        mx = fmaxf(mx, shfl_xor_l(mx, 32, lane));
        float l = 0.f;
#pragma unroll
        for (int kb = 0; kb < 4; ++kb) if (kb < nblk) {
#pragma unroll
            for (int i = 0; i < 16; ++i) { const float s = sc[kb][i]; const float pv = s > -1e29f ? __builtin_amdgcn_exp2f(s - mx) : 0.f; sc[kb][i] = pv; l += pv; }
        }
        l += shfl_xor_l(l, 32, lane);
        const float inv = l > 0.f ? 1.f / l : 0.f;
#pragma unroll
        for (int db = 0; db < 4; ++db) oacc[db] = ZERO16;
#pragma unroll
        for (int kb = 0; kb < 4; ++kb) if (kb < nblk) {
            sc[kb] = sc[kb] * inv;
            if (dosel) {
#pragma unroll
                for (int s2 = 0; s2 < 2; ++s2) {
                    LAS float* ip = IMPH + (hl * 64 + ql) * 33 + 8 * kb + 4 * s2 + 2 * h;
                    const float a = (sc[kb][8 * s2] + sc[kb][8 * s2 + 1]) + (sc[kb][8 * s2 + 2] + sc[kb][8 * s2 + 3]);
                    const float bq = ((sc[kb][8 * s2 + 4] + sc[kb][8 * s2 + 5]) + (sc[kb][8 * s2 + 6] + sc[kb][8 * s2 + 7])) + sc[kb][8 * s2 + 3];
                    __hip_atomic_fetch_add(ip, a, __ATOMIC_RELAXED, __HIP_MEMORY_SCOPE_WORKGROUP);
                    __hip_atomic_fetch_add(ip + 1, bq, __ATOMIC_RELAXED, __HIP_MEMORY_SCOPE_WORKGROUP);
                    __hip_atomic_fetch_add(ip + 2, sc[kb][8 * s2 + 7], __ATOMIC_RELAXED, __HIP_MEMORY_SCOPE_WORKGROUP);
                }
            }
#pragma unroll
            for (int s2 = 0; s2 < 2; ++s2) {
                const bf16x8 pf = pack_frag(sc[kb], s2);
#pragma unroll
                for (int db = 0; db < 4; ++db) { const bf16x8 a = *(const LAS bf16x8*)(lds + A_VB + vbase + (4 * kb + 2 * s2) * 2048 + db * 512); oacc[db] = __builtin_amdgcn_mfma_f32_32x32x16_bf16(a, pf, oacc[db], 0, 0, 0); }
            }
        }
        { const float g0 = ((const float*)(ws + WS_GS))[tok * 48 + head];
#pragma unroll
          for (int db = 0; db < 4; ++db) {
#pragma unroll
              for (int k = 0; k < 8; ++k) ofp[db][k] = cvt_pk_bf16(oacc[db][2 * k] * g0, oacc[db][2 * k + 1] * g0);
              oacc[db] = ZERO16; } }
    }
    block_sync();
    const bf16_t* KVp = (const bf16_t*)(ws + WS_KV);
    const unsigned ldoff = (unsigned)(wave * 1024 + lane * 8);
#define ATT_ISSUE(br_, s_, buf_) do { const bf16_t* Kt_ = KVp + (size_t)((br_) == 1 ? 2 : 4) * KV_SLAB + ((size_t)bg * 32 + (s_)) * 8192 + ldoff; \
        const bf16_t* Vt_ = KVp + (size_t)((br_) == 1 ? 3 : 5) * KV_SLAB + ((size_t)bg * 32 + (s_)) * 8192 + ldoff; \
        _Pragma("unroll") for (int i_ = 0; i_ < 2; ++i_) __builtin_amdgcn_global_load_lds((const unsigned*)(Kt_ + i_ * 512), (LAS unsigned*)(lds + A_KB + (buf_) * 16384 + (wave * 2 + i_) * 1024), 16, 0, 0); \
        _Pragma("unroll") for (int i_ = 0; i_ < 2; ++i_) __builtin_amdgcn_global_load_lds((const unsigned*)(Vt_ + i_ * 512), (LAS unsigned*)(lds + A_VB + (buf_) * 16384 + (wave * 2 + i_) * 1024), 16, 0, 0); } while (0)
    ATT_ISSUE(1, 0, 0);
    if (dosel) {
        const int q = tid >> 3, sg = tid & 7, tqq = t0 + q;
#pragma unroll
        for (int j = 0; j < 4; ++j) { const int s = sg * 4 + j;
            float v = (IMPH[(0 * 64 + q) * 33 + s] + IMPH[(1 * 64 + q) * 33 + s]) + (IMPH[(2 * 64 + q) * 33 + s] + IMPH[(3 * 64 + q) * 33 + s]);
            const bool fut = s * 64 > tqq, forced = (s == 0) || (s == qi) || (s == qi - 1);
            IMPF[q * 33 + s] = fut ? -1.f : (v + (forced ? 1e4f : 0.f)); }
        asm volatile("s_waitcnt lgkmcnt(0)" ::: "memory"); __builtin_amdgcn_s_barrier(); asm volatile("" ::: "memory");
        unsigned bits = 0;
        { float ov[32];
#pragma unroll
          for (int s2 = 0; s2 < 32; ++s2) ov[s2] = IMPF[q * 33 + s2];
#pragma unroll
          for (int j = 0; j < 4; ++j) { const int s = sg * 4 + j; const float v = IMPF[q * 33 + s]; int cnt = 0;
#pragma unroll
              for (int s2 = 0; s2 < 32; ++s2) cnt += (ov[s2] > v || (ov[s2] == v && s2 < s)) ? 1 : 0;
              if (cnt < 16) bits |= 1u << s; } }
        __hip_atomic_fetch_or(SEL + q, bits, __ATOMIC_RELAXED, __HIP_MEMORY_SCOPE_WORKGROUP);
        __hip_atomic_fetch_or(UNI, bits, __ATOMIC_RELAXED, __HIP_MEMORY_SCOPE_WORKGROUP);
    }
    block_sync();
    const unsigned selw = SEL[ql];
    const unsigned uni = (unsigned)__builtin_amdgcn_readfirstlane((int)UNI[0]);
    const unsigned causal_blocks = qi == 31 ? 0xffffffffu : ((2u << qi) - 1u);
    const float b31 = BTh[127];
    constexpr float MASKV = -30000.f, MINIT = -20000.f;
    float m = MINIT, l = 0.f;
    int br = 1, s = 0, buf = 0;
    while (br != 3) {
        int nbr, ns;
        if (br == 1) { const unsigned mk = uni & causal_blocks & ~((2u << s) - 1u); if (s < 31 && mk) { nbr = 1; ns = __builtin_ctz(mk); } else { nbr = 2; ns = max(0, qi - 8); } }
        else { if (s + 1 <= qi) { nbr = 2; ns = s + 1; } else { nbr = 3; ns = 0; } }
        if (nbr != 3) ATT_ISSUE(nbr, ns, buf ^ 1);
        const int kbase = s * 64;
        const bool need_elem = (kbase + 63 + 128 > t0) || (br == 2 && (t0 + 63 - kbase >= 512));
        const bool lanebit = br == 1 ? ((selw >> s) & 1u) != 0u : true;
        if (__builtin_amdgcn_ballot_w64(lanebit) != 0ull) {
        f32x16 sc[2];
        float mx = -1e30f;
        sc[0] = ZERO16; sc[1] = ZERO16;
        {
            const LAS unsigned char* kp = lds + A_KB + buf * 16384 + ktbase;
            bf16x8 ka[4][2];
#pragma unroll
            for (int kk = 0; kk < 4; ++kk) { ka[kk][0] = *(const LAS bf16x8*)(kp + kk * 2048); ka[kk][1] = *(const LAS bf16x8*)(kp + 512 + kk * 2048); }
#pragma unroll
            for (int kk = 0; kk < 8; ++kk) {
                sc[0] = __builtin_amdgcn_mfma_f32_32x32x16_bf16(ka[kk & 3][0], qf[kk], sc[0], 0, 0, 0);
                sc[1] = __builtin_amdgcn_mfma_f32_32x32x16_bf16(ka[kk & 3][1], qf[kk], sc[1], 0, 0, 0);
                if (kk < 4) { ka[kk][0] = *(const LAS bf16x8*)(kp + (kk + 4) * 2048); ka[kk][1] = *(const LAS bf16x8*)(kp + 512 + (kk + 4) * 2048); }
            }
        }
        float alpha, ls = 0.f;
        if (need_elem) {
            const int wlim = br == 1 ? 0x7fffffff : 512;
#pragma unroll
            for (int kb = 0; kb < 2; ++kb) {
                float bias[16];
#pragma unroll
                for (int i = 0; i < 16; ++i) { const int key = kbase + 32 * kb + 16 * (i >> 3) + 8 * h + (i & 7); bias[i] = BTh[min(max(tq - key, 0), 127)]; }
#pragma unroll
                for (int i = 0; i < 16; ++i) asm volatile("" : "+v"(bias[i]));
#pragma unroll
                for (int i = 0; i < 16; ++i) {
                    const int key = kbase + 32 * kb + 16 * (i >> 3) + 8 * h + (i & 7);
                    const int dist = tq - key;
                    const float sv = (lanebit && dist >= 0 && dist < wlim) ? sc[kb][i] + bias[i] : MASKV;
                    sc[kb][i] = sv; mx = fmaxf(mx, sv);
                }
            }
            mx = fmaxf(mx, shfl_xor_l(mx, 32, lane));
            const float mnew = fmaxf(m, mx);
            alpha = __builtin_amdgcn_exp2f(m - mnew);
            m = mnew;
#pragma unroll
            for (int kb = 0; kb < 2; ++kb)
#pragma unroll
                for (int i = 0; i < 16; ++i) { const float pv = __builtin_amdgcn_exp2f(sc[kb][i] - mnew); sc[kb][i] = pv; ls += pv; }
        } else {
            const float bl = lanebit ? b31 : MASKV;
#pragma unroll
            for (int kb = 0; kb < 2; ++kb)
#pragma unroll
                for (int i = 0; i < 16; ++i) mx = fmaxf(mx, sc[kb][i]);
            mx = fmaxf(mx, shfl_xor_l(mx, 32, lane));
            const float mnew = fmaxf(m, mx + bl);
            alpha = __builtin_amdgcn_exp2f(m - mnew);
            m = mnew;
            const float cc = bl - mnew;
#pragma unroll
            for (int kb = 0; kb < 2; ++kb)
#pragma unroll
                for (int i = 0; i < 16; ++i) { const float pv = __builtin_amdgcn_exp2f(sc[kb][i] + cc); sc[kb][i] = pv; ls += pv; }
        }
        l = l * alpha + ls;
        if (__builtin_amdgcn_ballot_w64(alpha != 1.f) != 0ull) {
#pragma unroll
            for (int db = 0; db < 4; ++db) oacc[db] = oacc[db] * alpha;
        }
        {
            const LAS unsigned char* vp = lds + A_VB + buf * 16384 + vbase;
            bf16x8 va[2][4];
#pragma unroll
            for (int gq = 0; gq < 2; ++gq)
#pragma unroll
                for (int db = 0; db < 4; ++db) va[gq][db] = *(const LAS bf16x8*)(vp + (2 * gq) * 2048 + db * 512);
#pragma unroll
            for (int gq = 0; gq < 4; ++gq) {
                const bf16x8 pf = pack_frag(sc[gq >> 1], gq & 1);
#pragma unroll
                for (int db = 0; db < 4; ++db) {
                    oacc[db] = __builtin_amdgcn_mfma_f32_32x32x16_bf16(va[gq & 1][db], pf, oacc[db], 0, 0, 0);
                    if (gq < 2) va[gq & 1][db] = *(const LAS bf16x8*)(vp + (2 * (gq + 2)) * 2048 + db * 512);
                }
            }
            __builtin_amdgcn_sched_group_barrier(0x100, 8, 0);
#pragma unroll
            for (int q_ = 0; q_ < 8; ++q_) { __builtin_amdgcn_sched_group_barrier(0x008, 1, 0); __builtin_amdgcn_sched_group_barrier(0x100, 1, 0); }
            __builtin_amdgcn_sched_group_barrier(0x008, 8, 0);
        }
        }
        if (nbr != br) {
            const float lt = l + shfl_xor_l(l, 32, lane);
            const float wgt = (lt > 0.f ? 1.f / lt : 0.f) * ((const float*)(ws + WS_GS))[tok * 48 + head + (br == 1 ? 16 : 32)];
#pragma unroll
            for (int db = 0; db < 4; ++db) {
#pragma unroll
                for (int k = 0; k < 8; ++k) ofp[db][k] = cvt_pk_bf16(bf_lo(ofp[db][k]) + oacc[db][2 * k] * wgt, bf_hi(ofp[db][k]) + oacc[db][2 * k + 1] * wgt);
                oacc[db] = ZERO16; }
            m = MINIT; l = 0.f;
        }
        block_sync();
        br = nbr; s = ns; buf ^= 1;
    }
    { const int tid2 = opaque_tid(); const int r2 = tid2 & 31, h2 = (tid2 >> 5) & 1;
      bf16_t* SGBp = (bf16_t*)(launder(p->ws) + WS_SGB) + ((size_t)b * 2048 + t0 + qh * 32 + r2) * 2048 + head * 128 + 4 * h2;
      u32x2 gq[4][4];
#pragma unroll
      for (int db = 0; db < 4; ++db)
#pragma unroll
          for (int aa = 0; aa < 4; ++aa) gq[db][aa] = *(const u32x2*)(SGBp + 32 * db + 8 * aa);
#pragma unroll
      for (int db = 0; db < 4; ++db)
#pragma unroll
          for (int aa = 0; aa < 4; ++aa) {
              bf16_t* po = SGBp + 32 * db + 8 * aa + (WS_XW - WS_SGB) / 2;
              const u32x2 g2 = gq[db][aa];
              u32x2 o; o.x = cvt_pk_bf16(bf_lo(ofp[db][2 * aa]) * silu_f(bf_lo(g2.x)), bf_hi(ofp[db][2 * aa]) * silu_f(bf_hi(g2.x))); o.y = cvt_pk_bf16(bf_lo(ofp[db][2 * aa + 1]) * silu_f(bf_lo(g2.y)), bf_hi(ofp[db][2 * aa + 1]) * silu_f(bf_hi(g2.y)));
              *(u32x2*)po = o;
          } }
#undef ATT_ISSUE
}
__device__ __forceinline__ void attn_phase(const KP p, int layer, LAS unsigned char* lds) {
    const int G = gridDim.x, c = blockIdx.x, x = c & 7;
    const int nbx = (G - x + 7) >> 3;
    unsigned* qctr = (unsigned*)(launder(p->ws) + WS_BAR) + 3584 + (layer * 8 + x) * 16;
    int j = c >> 3;
    while (j < 128) {
        const int qi = 31 - (j >> 2), bg = ((j & 3) << 3) + x;
        attn_item(p, layer, lds, bg >> 2, bg & 3, qi, qctr);
        block_sync();
        j = nbx + __builtin_amdgcn_readfirstlane((int)*(volatile LAS unsigned*)(lds + 135936));
    }
}
#endif


#define XB_TMO      128
#define XB_XCNT(j)  (256  + 64 * (j))
#define XB_XSUB(j)  (1280 + 64 * (j))
#define XB_XGEN(j)  (2304 + 64 * (j))
#define XB_TOP      3328
#define XB_TOPGEN   3392
#define XCD_BAR_WORDS 3456
#define XB_SPIN_CAP (1u << 20)
__device__ __forceinline__ unsigned xb_ld(unsigned* p)              { return __hip_atomic_load(p, __ATOMIC_RELAXED, __HIP_MEMORY_SCOPE_AGENT); }
__device__ __forceinline__ unsigned xb_add(unsigned* p, unsigned v) { return __hip_atomic_fetch_add(p, v, __ATOMIC_RELAXED, __HIP_MEMORY_SCOPE_AGENT); }
__device__ __forceinline__ unsigned xb_xcc_id() { return (unsigned)__builtin_amdgcn_s_getreg((3 << 11) | 20) & 0xFu; }
#define XB_SPIN(cond, bar) do { unsigned _sp = 0; while (cond) { __builtin_amdgcn_s_sleep(1); \
    if ((++_sp & 255u) == 0u) { if (xb_ld(&(bar)[XB_TMO])) break; if (_sp > XB_SPIN_CAP) { atomicAdd(&(bar)[XB_TMO], 1u); break; } } } } while (0)
struct XcdBarrier { unsigned* bar; unsigned x; volatile LAS unsigned* st; };
__device__ __forceinline__ XcdBarrier xcd_barrier_post(unsigned* bar, volatile LAS unsigned* st) {
    XcdBarrier b; b.bar = bar; b.x = xb_xcc_id(); b.st = st;
    if (opaque_tid() == 0) (void)xb_add(&bar[XB_XCNT(b.x)], 1u);
    return b;
}
__device__ __forceinline__ void xcd_barrier_complete(unsigned* bar, unsigned x, unsigned& nloc, unsigned& nx) {
    const unsigned G = gridDim.x * gridDim.y * gridDim.z;
    unsigned sum, cnt, mine, sp = 0u;
    for (;;) {
        sum = 0u; cnt = 0u; mine = 0u;
#pragma unroll
        for (unsigned j = 0; j < 16; ++j) { const unsigned c = xb_ld(&bar[XB_XCNT(j)]); sum += c; cnt += (c > 0u) ? 1u : 0u; mine = (j == x) ? c : mine; }
        if (sum == G) break;
        __builtin_amdgcn_s_sleep(1);
        if ((++sp & 255u) == 0u) { if (xb_ld(&bar[XB_TMO])) break; if (sp > XB_SPIN_CAP) { atomicAdd(&bar[XB_TMO], 1u); break; } }
    }
    nloc = mine > 0u ? mine : 1u; nx = cnt > 0u ? cnt : 1u;
}
__device__ __forceinline__ void xcd_barrier(const XcdBarrier& b) {
    asm volatile("s_waitcnt vmcnt(0)" ::: "memory");
    __syncthreads();
    if (opaque_tid() == 0) {
        unsigned* bar = b.bar;
        __builtin_amdgcn_s_waitcnt(0);
        unsigned nloc = b.st[0], nx = b.st[1];
        if (nloc == 0u) { xcd_barrier_complete(bar, b.x, nloc, nx); b.st[0] = nloc; b.st[1] = nx; }
        const unsigned old = xb_add(&bar[XB_XSUB(b.x)], 1u);
        const unsigned gen = old / nloc;
        if (old + 1u == (gen + 1u) * nloc) {
            __builtin_amdgcn_fence(__ATOMIC_RELEASE, "agent");
            asm volatile("s_waitcnt vmcnt(0)" ::: "memory");
            const unsigned og = xb_add(&bar[XB_TOP], 1u);
            const unsigned tg = og / nx;
            if (og + 1u == (tg + 1u) * nx) xb_add(&bar[XB_TOPGEN], 1u);
            else XB_SPIN(xb_ld(&bar[XB_TOPGEN]) == tg, bar);
            __builtin_amdgcn_fence(__ATOMIC_ACQUIRE, "agent");
            xb_add(&bar[XB_XGEN(b.x)], 1u);
            asm volatile("s_waitcnt vmcnt(0)" ::: "memory");
        } else {
            XB_SPIN(xb_ld(&bar[XB_XGEN(b.x)]) == gen, bar);
            __builtin_amdgcn_fence(__ATOMIC_ACQUIRE, "agent");
            asm volatile("s_waitcnt vmcnt(0)" ::: "memory");
        }
    }
    __syncthreads();
}

#define CG_SYNC() do { __builtin_amdgcn_fence(__ATOMIC_RELEASE, "agent"); grid.sync(); __builtin_amdgcn_fence(__ATOMIC_ACQUIRE, "agent"); } while (0)
#define GRID_SYNC() do { XcdBarrier xb_; xb_.bar = (unsigned*)(launder(p->ws) + WS_BAR); xb_.x = xb_xcc_id(); xb_.st = (volatile LAS unsigned*)(lds + 135168); xcd_barrier(xb_); } while (0)

__global__ void __launch_bounds__(512) mega(Params p_arg) {
    const KP p = (KP)__builtin_amdgcn_kernarg_segment_ptr();
    LAS unsigned char* lds = (LAS unsigned char*)lds_raw;
    { const int t0_ = threadIdx.x; if ((t0_ & 63) == 0) *(volatile LAS int*)(lds + TID_TAB_OFF + hw_slot() * 4) = t0_ >> 6; asm volatile("s_waitcnt lgkmcnt(0)" ::: "memory"); }
    cg::grid_group grid = cg::this_grid();
    unsigned char* ws = p->ws;
    const int G = gridDim.x, c = blockIdx.x;

#ifndef REP_PREP
#define REP_PREP 1
#endif
    unsigned* barw = (unsigned*)(ws + WS_BAR);
    volatile LAS unsigned* xst = (volatile LAS unsigned*)(lds + 135168);
    { const int t_ = opaque_tid(); if (t_ < 2) xst[t_] = 0u; }
    __syncthreads();
    (void)xcd_barrier_post(barw, xst);
    if (ws == nullptr) CG_SYNC();
    for (int rep = 0; rep < REP_PREP; ++rep) prep_phase(p, lds);
    GRID_SYNC();
    {
        if (c == G - 1) { const int t = opaque_tid(); const float* bp = (const float*)(ws + WS_B1P) + (size_t)(t >> 7) * 1024 + (t & 127); float s = 0.f;
#pragma unroll
            for (int q = 0; q < 8; ++q) s += bp[q * 128];
            ((float*)(ws + WS_BIAS1))[t] = s; }
        SchedFold S{(const char*)(ws + WS_WGRPT), (const char*)(ws + WS_WCXN), G, c};
        EpiFold E{ws};
#ifndef NO_FOLD
        pg8::gemm_phase(lds, 512, 512, 2048, S, E);
#endif
        rms_mod_phase(p->in[I_X], p->in[I_NORMG], (const float*)(ws + WS_MOD), (bf16_t*)(ws + WS_H));
    }
    GRID_SYNC();
    for (int layer = 0; layer < 2; ++layer) {
        {
            SchedStd S{(const char*)(ws + WS_H), (const char*)(ws + WS_WINT) + (size_t)layer * NPAD * 2048 * 2, 2048, 2048, 64, 92, 1, 0, 0, G, c};
            EpiMain E{ws, layer};
#ifndef REP_MAIN
#define REP_MAIN 1
#endif
            for (int rep = 0; rep < REP_MAIN; ++rep) pg8::gemm_phase(lds, 2048, 2048, 2048, S, E);
        }
        GRID_SYNC();
        {
#if EN_B
            SchedL3a S{(const char*)(ws + WS_KV), (const char*)(ws + WS_W1T) + (size_t)layer * 2 * 256 * 2048 * 2, (const char*)(ws + WS_H),
                       (const char*)(ws + WS_WINT) + ((size_t)layer * NPAD + 23552) * 2048 * 2, G, c};
            EpiCmp E{ws};
            pg8::gemm_phase(lds, 2048, 2048, 2048, S, E);
            if (c < 32) {
                __builtin_amdgcn_fence(__ATOMIC_ACQUIRE, "agent");
                kcvc_item(p, layer, 2 * (c & 15), c >> 4); kcvc_item(p, layer, 2 * (c & 15) + 1, c >> 4);
            }
#endif
#if EN_A
            {
                unsigned* qctr = (unsigned*)(launder(p->ws) + WS_BAR) + 3840 + layer * 64;
                const int nstat = G > 96 ? G - 96 : 0;
                int it;
                if (c >= 96) it = c - 96;
                else { if (opaque_tid() == 0) *(volatile LAS unsigned*)(lds + 135936) = __hip_atomic_fetch_add(qctr, 1u, __ATOMIC_RELAXED, __HIP_MEMORY_SCOPE_AGENT);
                       block_sync(); it = nstat + __builtin_amdgcn_readfirstlane((int)*(volatile LAS unsigned*)(lds + 135936)); }
                while (it < 1024) {
                    amix_item(p, layer, lds, it, qctr);
                    it = nstat + __builtin_amdgcn_readfirstlane((int)*(volatile LAS unsigned*)(lds + 135936));
                }
            }
#endif
#if EN_C
            for (int it = c; it < 512; it += G) cpool_item(p, layer, it);
#endif
        }
        GRID_SYNC();
#if EN_B
#ifndef REP_ATT
#define REP_ATT 1
#endif
        for (int rep = 0; rep < REP_ATT; ++rep) attn_phase(p, layer, lds);
        GRID_SYNC();
#endif
        {
            SchedBranch S{(const char*)(ws + WS_U), (const char*)(ws + WS_XW), (const char*)(ws + WS_SGC), (const char*)(ws + WS_WBRT) + (size_t)layer * 3 * 2048 * 2048 * 2, G, c};
            EpiBranch E{ws};
#ifndef REP_BR
#define REP_BR 1
#endif
            for (int rep = 0; rep < REP_BR; ++rep) pg8::gemm_phase(lds, 2048, 2048, 2048, S, E);
        }
        GRID_SYNC();
        {
            SchedStd S{(const char*)(ws + WS_V), (const char*)(ws + WS_WOUTT) + (size_t)layer * 2048 * 2048 * 2, 2048, 2048, 64, 8, 1, 0, 0, G, c};
            EpiOut E{layer == 0 ? p->in[I_X] : (const float*)(ws + WS_XRES), layer == 0 ? (float*)(ws + WS_XRES) : p->out, (const float*)(ws + WS_MOD) + (size_t)layer * 8 * 6144 + 4096};
#ifndef REP_OUT
#define REP_OUT 1
#endif
            for (int rep = 0; rep < REP_OUT; ++rep) pg8::gemm_phase(lds, 2048, 2048, 2048, S, E);
        }
        GRID_SYNC();
        if (layer == 0) {
            rms_mod_phase((const float*)(ws + WS_XRES), p->in[I_NORMG] + 2048, (const float*)(ws + WS_MOD) + 8 * 6144, (bf16_t*)(ws + WS_H));
            GRID_SYNC();
        }
    }
#ifdef EXTRA_SYNCS
    for (int q = 0; q < EXTRA_SYNCS; ++q) GRID_SYNC();
#endif
    final_rms_phase(p->out, p->in[I_FINALG]);
}

extern "C" void kernel_launch(void* const* d_in, const int* in_sizes, int n_in, void* d_out, int out_size, void* d_ws, size_t ws_size, hipStream_t stream) {
    static int grid_blocks = 0;
    if (!grid_blocks) {
        int dev = 0, cus = 0, per_cu = 0;
        (void)hipGetDevice(&dev);
        (void)hipDeviceGetAttribute(&cus, hipDeviceAttributeMultiprocessorCount, dev);
        (void)hipFuncSetAttribute((const void*)mega, hipFuncAttributeMaxDynamicSharedMemorySize, LDS_BYTES);
        (void)hipOccupancyMaxActiveBlocksPerMultiprocessor(&per_cu, (const void*)mega, 512, LDS_BYTES);
        if (per_cu < 1) per_cu = 1;
        grid_blocks = cus * per_cu;
        if (ws_size < WS_END) fprintf(stderr, "workspace too small: %zu < %zu\n", ws_size, (size_t)WS_END);
    }
    Params p{};
    for (int i = 0; i < 19; ++i) p.in[i] = (const float*)d_in[i];
    p.out = (float*)d_out; p.ws = (unsigned char*)d_ws;
    (void)hipMemsetAsync((unsigned char*)d_ws + WS_BAR, 0, 16384, stream);
    void* args[] = {&p};
    hipError_t e = hipLaunchCooperativeKernel((void*)mega, dim3(grid_blocks), dim3(512), args, LDS_BYTES, stream);
    if (e != hipSuccess) fprintf(stderr, "cooperative launch failed: %s (grid %d)\n", hipGetErrorString(e), grid_blocks);
}
```

```cpp
#include <hip/hip_runtime.h>
#include <hip/hip_cooperative_groups.h>
#include <cstdio>
#include <cstdint>
namespace cg = cooperative_groups;

#ifndef EN_A
#define EN_A 1
#endif
#ifndef EN_B
#define EN_B 1
#endif
#ifndef EN_C
#define EN_C 1
#endif

#define LAS __attribute__((address_space(3)))
typedef unsigned short bf16_t;
typedef short bf16x8 __attribute__((ext_vector_type(8)));
typedef float f32x4 __attribute__((ext_vector_type(4)));
typedef float f32x16 __attribute__((ext_vector_type(16)));
typedef unsigned u32x4 __attribute__((ext_vector_type(4)));
typedef unsigned u32x2 __attribute__((ext_vector_type(2)));

constexpr int D = 2048, SEQ = 2048, NB = 8, NTOK = NB * SEQ;
constexpr int NCOLS = 23600;
constexpr int NPAD = 23808;
constexpr int LDS_BYTES = 136 * 1024;
constexpr float LOG2E = 1.4426950408889634f;

constexpr size_t SZ_ACT = (size_t)NTOK * 2048 * 2;
constexpr size_t WS_WINT = 0;
constexpr size_t WS_WCXN = WS_WINT + (size_t)2 * NPAD * 2048 * 2;
constexpr size_t WS_WBRT = WS_WCXN + (size_t)2 * 2048 * 2048 * 2;
constexpr size_t WS_WOUTT = WS_WBRT + (size_t)6 * 2048 * 2048 * 2;
constexpr size_t WS_WGRPT = WS_WOUTT + (size_t)2 * 2048 * 2048 * 2;
constexpr size_t WS_WSM = WS_WGRPT + (size_t)8 * 512 * 512 * 2;
constexpr size_t WS_W1T = WS_WSM + (size_t)16 * 128 * 128 * 2;
constexpr size_t WS_W2T = WS_W1T + (size_t)4 * 256 * 2048 * 2;
constexpr size_t WS_BIAS1 = WS_W2T + (size_t)4 * 128 * 128 * 2;
constexpr size_t WS_MOD = WS_BIAS1 + 4096;
constexpr size_t WS_STATS = WS_MOD + (size_t)2 * 8 * 6144 * 4;
constexpr size_t WS_GS = WS_STATS + (size_t)2 * NTOK * 2 * 4;
constexpr size_t WS_PQ = WS_GS + (size_t)NTOK * 48 * 4;
constexpr size_t WS_H = WS_PQ + (size_t)2 * 4096 * 256 * 4 + 65536;
constexpr size_t WS_U = WS_H + SZ_ACT;
constexpr size_t WS_V = WS_U + SZ_ACT;
constexpr size_t WS_SG = WS_V + SZ_ACT;
constexpr size_t WS_Q = WS_SG + SZ_ACT;
constexpr size_t WS_SGB = WS_Q + SZ_ACT;
constexpr size_t WS_XW = WS_SGB + SZ_ACT;
constexpr size_t WS_SGC = WS_XW + SZ_ACT;
constexpr size_t WS_KV = WS_SGC + SZ_ACT;
constexpr size_t KV_SLAB = (size_t)NTOK * 512;
constexpr size_t WS_MG = WS_KV + 6 * KV_SLAB * 2 + (1 << 20);
constexpr size_t WS_XRES = WS_MG + (size_t)NTOK * 6144 * 2;
constexpr size_t WS_STATP = WS_XRES + (size_t)NTOK * 2048 * 4;
constexpr size_t WS_B1P = WS_STATP + (size_t)32 * NTOK * 2 * 4;
constexpr size_t WS_BAR = WS_B1P + 16384;
constexpr size_t WS_KCI = WS_BAR + 16384;
constexpr size_t WS_END = WS_KCI + (size_t)64 * 32768;

struct Params {
    const float* in[19];
    float* out;
    unsigned char* ws;
};
typedef const __attribute__((address_space(4))) Params* KP;
enum { I_X = 0, I_C, I_RELB, I_NORMG, I_WADA, I_BADA, I_WIN, I_ALNG, I_ALNB, I_AWS, I_ABS, I_WCMP1, I_WCMP2, I_POSCMP, I_CWGRP, I_CSCALE, I_WBR, I_WOUT, I_FINALG };

typedef float f32x2_t __attribute__((ext_vector_type(2)));
typedef __bf16 bf16x2_t __attribute__((ext_vector_type(2)));
__device__ __forceinline__ unsigned cvt_pk_bf16(float lo, float hi) { const f32x2_t v = {lo, hi}; return __builtin_bit_cast(unsigned, __builtin_convertvector(v, bf16x2_t)); }
__device__ __forceinline__ float bf_lo(unsigned w) { return __uint_as_float(w << 16); }
__device__ __forceinline__ float bf_hi(unsigned w) { return __uint_as_float(w & 0xffff0000u); }
__device__ __forceinline__ float sigmoid_f(float x) { return __builtin_amdgcn_rcpf(1.f + __expf(-x)); }
__device__ __forceinline__ float silu_f(float x) { return x * sigmoid_f(x); }
__device__ __forceinline__ float gelu_f(float x) { const float u = 1.5957691216057308f * (x + 0.044715f * x * x * x); return x * sigmoid_f(u); }
__device__ __forceinline__ float shfl_xor_l(float v, int o, int lane) { return __builtin_bit_cast(float, __builtin_amdgcn_ds_bpermute(((lane ^ o) & 63) << 2, __builtin_bit_cast(int, v))); }
__device__ __forceinline__ float wave_sum(float v, int lane) {
#pragma unroll
    for (int o = 1; o < 64; o <<= 1) v += shfl_xor_l(v, o, lane);
    return v;
}
template <class T> __device__ __forceinline__ T* launder(T* p) { size_t z = 0; asm volatile("" : "+s"(z)); return (T*)((unsigned char*)p + z); }
extern __shared__ __attribute__((aligned(16))) unsigned char lds_raw[];
constexpr int TID_TAB_OFF = 135424;
__device__ __forceinline__ int hw_slot() { return (int)(__builtin_amdgcn_s_getreg((5 << 11) | 4) & 63u); }
__device__ __forceinline__ int opaque_tid() {
    unsigned z = 0u; asm volatile("" : "+v"(z));
    const int lane = (int)__builtin_amdgcn_mbcnt_hi(~0u, __builtin_amdgcn_mbcnt_lo(~0u, z));
    const int w = *(volatile LAS int*)((LAS unsigned char*)lds_raw + TID_TAB_OFF + hw_slot() * 4);
    int t = (w << 6) | lane; asm volatile("" : "+v"(t)); return t;
}
#define WAIT_VM0() asm volatile("s_waitcnt vmcnt(0)" ::: "memory")
#define WAIT_LGKM0() asm volatile("s_waitcnt lgkmcnt(0)" ::: "memory")
__device__ __forceinline__ void block_sync() { asm volatile("s_waitcnt vmcnt(0) lgkmcnt(0)" ::: "memory"); __builtin_amdgcn_s_barrier(); asm volatile("" ::: "memory"); }

namespace pg8 {
constexpr int BM = 256, BK = 64, HALF = 128, HTB = HALF * BK * 2, NXCD = 8, WGM = 8;
__device__ __forceinline__ int lds_byte(int r, int c) { const int st = (r >> 4) * 2 + (c >> 5), rr = r & 15, cc = c & 31, ob = rr * 64 + cc * 2; return st * 1024 + (ob ^ (((ob >> 9) & 1) << 5)); }
__device__ __forceinline__ void stage_rc(int b, int& R, int& C) { const int st = b / 1024, sb = b % 1024, swz = sb ^ (((sb >> 9) & 1) << 5); R = (st >> 1) * 16 + swz / 64; C = (st & 1) * 32 + (swz % 64) / 2; }
__device__ __forceinline__ int perm32(int rho) { const int n = rho >> 4, i = rho & 15; return 8 * (i >> 2) + 4 * n + (i & 3); }
struct Unit { int pm, pn, z; };
__device__ __forceinline__ void tile_swizzle(int wgid, int nM, int nN, int& pm, int& pn) {
    const int nwg = nM * nN;
    { const int q = nwg / NXCD, r = nwg % NXCD, xcd = wgid % NXCD, off = wgid / NXCD; wgid = (xcd < r ? xcd * (q + 1) : r * (q + 1) + (xcd - r) * q) + off; }
    const int nig = WGM * nN, gid = wgid / nig, fm = gid * WGM, gsz = (nM - fm) < WGM ? (nM - fm) : WGM;
    pm = fm + ((wgid % nig) % gsz); pn = (wgid % nig) / gsz;
}
template <class Sched, class Epi>
__device__ __forceinline__ void gemm_phase(LAS unsigned char* lds, const int K, const int lda, const int ldb, const Sched& S, const Epi& E) {
    const int tid = opaque_tid(), wid = __builtin_amdgcn_readfirstlane(tid >> 6), lane = tid & 63, wr = wid >> 2, wc = wid & 3, fr = lane & 15, fq = lane >> 4;
    const int nt = K / BK;
    unsigned voffA[2], voffB[2];
#pragma unroll
    for (int i = 0; i < 2; ++i) { int R, C; stage_rc(tid * 16 + i * 8192, R, C); const int Rb = (R & ~31) + perm32(R & 31);
        voffA[i] = (unsigned)(R * lda + C) * 2u; voffB[i] = (unsigned)(Rb * ldb + C) * 2u; }
    const size_t kstep = (size_t)(BK * 2);
    const size_t hstepA = (size_t)HALF * lda * 2, hstepB = (size_t)HALF * ldb * 2;
    const unsigned ldsw = (unsigned)wid * 1024u;
    const int aoff = lds_byte(wr * 64 + fr, fq * 8), boff = lds_byte(wc * 32 + fr, fq * 8);
#define PG8_SA(b, h) (((b) * 2 + (h)) * HTB)
#define PG8_SB(b, h) ((4 + (b) * 2 + (h)) * HTB)
#define PG8_STAGE(bufoff, gbase, voff) do { _Pragma("unroll") for (int _i = 0; _i < 2; ++_i) \
        __builtin_amdgcn_global_load_lds((const unsigned*)((const char*)(gbase) + (voff)[_i]), (LAS unsigned*)(lds + (bufoff) + ldsw + _i * 8192), 16, 0, 0); } while (0)
#define PG8_LDA(dst, b, h) do { _Pragma("unroll") for (int m = 0; m < 4; ++m) _Pragma("unroll") for (int k = 0; k < 2; ++k) dst[m][k] = *(const LAS bf16x8*)(lds + PG8_SA(b, h) + aoff + m * 2048 + k * 1024); } while (0)
#define PG8_LDB(dst, b, h) do { _Pragma("unroll") for (int n = 0; n < 2; ++n) _Pragma("unroll") for (int k = 0; k < 2; ++k) dst[n][k] = *(const LAS bf16x8*)(lds + PG8_SB(b, h) + boff + n * 2048 + k * 1024); } while (0)
#define PG8_MMA(ai, bj, At, Bt) do { __builtin_amdgcn_s_setprio(1); _Pragma("unroll") for (int m = 0; m < 4; ++m) _Pragma("unroll") for (int n = 0; n < 2; ++n) _Pragma("unroll") for (int k = 0; k < 2; ++k) \
        acc[ai][bj][m][n] = __builtin_amdgcn_mfma_f32_16x16x32_bf16(Bt[n][k], At[m][k], acc[ai][bj][m][n], 0, 0, 0); __builtin_amdgcn_s_setprio(0); } while (0)
#define PG8_WAIT_V(n) asm volatile("s_waitcnt vmcnt(" #n ")" ::: "memory")
#define PG8_WAIT_L(n) asm volatile("s_waitcnt lgkmcnt(" #n ")" ::: "memory")
#define PG8_BAR __builtin_amdgcn_s_barrier()
#define PG8_SCHED __builtin_amdgcn_sched_barrier(0)
    Unit cur, nxt; int ui = 0;
    if (!S.next(0, cur)) return;
    f32x4 acc[2][2][4][2];
#pragma unroll
    for (int a = 0; a < 2; ++a)
#pragma unroll
        for (int b = 0; b < 2; ++b)
#pragma unroll
            for (int m = 0; m < 4; ++m)
#pragma unroll
                for (int n = 0; n < 2; ++n) acc[a][b][m][n] = (f32x4){0.f, 0.f, 0.f, 0.f};
    bf16x8 At[4][2], B0[2][2], B1[2][2];
    const char* cA = launder(S.abase(cur)); const char* cB = launder(S.bbase(cur));
    PG8_STAGE(PG8_SB(0, 0), cB, voffB); PG8_STAGE(PG8_SA(0, 0), cA, voffA); PG8_STAGE(PG8_SB(0, 1), cB + hstepB, voffB); PG8_STAGE(PG8_SA(0, 1), cA + hstepA, voffA);
    if (wr == 1) PG8_BAR;
    PG8_WAIT_V(4); PG8_BAR;
    PG8_STAGE(PG8_SB(1, 0), cB + kstep, voffB); PG8_STAGE(PG8_SA(1, 0), cA + kstep, voffA); PG8_STAGE(PG8_SB(1, 1), cB + hstepB + kstep, voffB);
    PG8_WAIT_V(6); PG8_BAR;
    for (;;) {
        const bool has_next = S.next(ui + 1, nxt);
        const char* nA = has_next ? launder(S.abase(nxt)) : cA; const char* nB = has_next ? launder(S.bbase(nxt)) : cB;
        for (int t = 0; t < nt; t += 2) {
            const bool last = (t == nt - 2);
            const char* a1 = cA + (size_t)(t + 1) * kstep;
            const char* a2 = last ? nA : cA + (size_t)(t + 2) * kstep; const char* b2 = last ? nB : cB + (size_t)(t + 2) * kstep;
            const char* a3 = a2 + kstep; const char* b3 = b2 + kstep;
            PG8_LDB(B0, 0, 0); PG8_SCHED; PG8_LDA(At, 0, 0); PG8_STAGE(PG8_SA(1, 1), a1 + hstepA, voffA);
            PG8_WAIT_L(8); PG8_BAR; PG8_WAIT_L(0); PG8_MMA(0, 0, At, B0); PG8_BAR; PG8_SCHED;
            PG8_LDB(B1, 0, 1); PG8_STAGE(PG8_SB(0, 0), b2, voffB);
            PG8_BAR; PG8_WAIT_L(0); PG8_MMA(0, 1, At, B1); PG8_BAR;
            PG8_LDA(At, 0, 1); PG8_STAGE(PG8_SA(0, 0), a2, voffA);
            PG8_BAR; PG8_WAIT_L(0); PG8_MMA(1, 0, At, B0); PG8_BAR; PG8_SCHED;
            PG8_STAGE(PG8_SB(0, 1), b2 + hstepB, voffB);
            PG8_WAIT_V(6); PG8_BAR; PG8_MMA(1, 1, At, B1); PG8_BAR;
            PG8_LDB(B0, 1, 0); PG8_SCHED; PG8_LDA(At, 1, 0); PG8_STAGE(PG8_SA(0, 1), a2 + hstepA, voffA);
            PG8_WAIT_L(8); PG8_BAR; PG8_WAIT_L(0); PG8_MMA(0, 0, At, B0); PG8_BAR; PG8_SCHED;
            PG8_LDB(B1, 1, 1); PG8_STAGE(PG8_SB(1, 0), b3, voffB);
            PG8_BAR; PG8_WAIT_L(0); PG8_MMA(0, 1, At, B1); PG8_BAR;
            PG8_LDA(At, 1, 1); PG8_STAGE(PG8_SA(1, 0), a3, voffA);
            PG8_BAR; PG8_WAIT_L(0); PG8_MMA(1, 0, At, B0); PG8_BAR; PG8_SCHED;
            PG8_STAGE(PG8_SB(1, 1), b3 + hstepB, voffB);
            PG8_WAIT_V(6); PG8_BAR; PG8_MMA(1, 1, At, B1); PG8_BAR;
        }
        E(acc, cur, wr, wc, fr, fq);
        if (!has_next) break;
#pragma unroll
        for (int a = 0; a < 2; ++a)
#pragma unroll
            for (int b = 0; b < 2; ++b)
#pragma unroll
                for (int m = 0; m < 4; ++m)
#pragma unroll
                    for (int n = 0; n < 2; ++n) acc[a][b][m][n] = (f32x4){0.f, 0.f, 0.f, 0.f};
        cur = nxt; cA = nA; cB = nB; ++ui;
    }
    PG8_WAIT_V(0);
    if (wr == 0) PG8_BAR;
    PG8_BAR;
#undef PG8_SA
#undef PG8_SB
#undef PG8_STAGE
#undef PG8_LDA
#undef PG8_LDB
#undef PG8_MMA
#undef PG8_WAIT_V
#undef PG8_WAIT_L
#undef PG8_BAR
#undef PG8_SCHED
}
}
using pg8::Unit;
typedef f32x4 AccT[2][2][4][2];

struct SchedStd {
    const char* A; const char* B; int lda, ldb, nM, nN, nZ; size_t zA, zB; int G, c;
    __device__ __forceinline__ bool next(int i, Unit& u) const {
        const long L = (long)i * G + c; const int per = nM * nN; if (L >= (long)per * nZ) return false;
        u.z = (int)(L / per); pg8::tile_swizzle((int)(L % per), nM, nN, u.pm, u.pn); return true; }
    __device__ __forceinline__ const char* abase(const Unit& u) const { return A + (size_t)u.z * zA + (size_t)u.pm * 256 * lda * 2; }
    __device__ __forceinline__ const char* bbase(const Unit& u) const { return B + (size_t)u.z * zB + (size_t)u.pn * 256 * ldb * 2; }
};
struct SchedFold {
    const char* A; const char* B; int G, c;
    __device__ __forceinline__ bool next(int i, Unit& u) const {
        const int L = i * G + c; if (L >= 128) return false; u.z = L >> 4; u.pm = (L >> 3) & 1; u.pn = L & 7; return true; }
    __device__ __forceinline__ const char* abase(const Unit& u) const { return A + (size_t)u.z * 512 * 512 * 2 + (size_t)u.pm * 256 * 512 * 2; }
    __device__ __forceinline__ const char* bbase(const Unit& u) const { return B + (size_t)(u.z >> 2) * 2048 * 2048 * 2 + (size_t)(u.z & 3) * 512 * 2 + (size_t)u.pn * 256 * 2048 * 2; }
};
struct SchedBranch {
    const char* A0; const char* A1; const char* A2; const char* B; int G, c;
    __device__ __forceinline__ bool next(int i, Unit& u) const {
        const int L = (i / 3) * G + c; if (L >= 512) return false; u.z = i % 3; pg8::tile_swizzle(L, 64, 8, u.pm, u.pn); return true; }
    __device__ __forceinline__ const char* abase(const Unit& u) const { const char* a = u.z == 0 ? A0 : (u.z == 1 ? A1 : A2); return a + (size_t)u.pm * 256 * 2048 * 2; }
    __device__ __forceinline__ const char* bbase(const Unit& u) const { return B + (size_t)u.z * 2048 * 2048 * 2 + (size_t)u.pn * 256 * 2048 * 2; }
};

struct SchedL3a {
    const char* KC; const char* W1; const char* H; const char* WG; int G, c;
    __device__ __forceinline__ bool next(int i, Unit& u) const {
        const int L = i * G + c; if (L >= 96) return false;
        if (L < 32) { u.z = L >> 4; u.pm = L & 15; u.pn = 0; } else { u.z = 2; u.pm = L - 32; u.pn = 0; }
        return true; }
    __device__ __forceinline__ const char* abase(const Unit& u) const { return (u.z == 2 ? H : KC + (size_t)u.z * 4096 * 2048 * 2) + (size_t)u.pm * 256 * 2048 * 2; }
    __device__ __forceinline__ const char* bbase(const Unit& u) const { return u.z == 2 ? WG : W1 + (size_t)u.z * 256 * 2048 * 2; }
};

#define EPI_ROW(ai, m) (u.pm * 256 + (ai) * 128 + wr * 64 + (m) * 16 + fr)
#define EPI_COLT(bj) ((bj) * 128 + wc * 32 + 8 * fq)
__device__ __forceinline__ u32x4 pack8(const f32x4 a, const f32x4 b) { u32x4 w; w.x = cvt_pk_bf16(a[0], a[1]); w.y = cvt_pk_bf16(a[2], a[3]); w.z = cvt_pk_bf16(b[0], b[1]); w.w = cvt_pk_bf16(b[2], b[3]); return w; }

struct EpiMain {
    unsigned char* ws0; int layer;
    __device__ __forceinline__ void operator()(const AccT& acc, const Unit& u, int wr, int wc, int fr, int fq) const {
        unsigned char* ws = launder(this->ws0);
        const int pn = u.pn;
        int act, store = 0, cb = 0, ldc = 2048; bf16_t* dst = nullptr; bool stats = false;
        if (pn < 8) { act = 0; dst = (bf16_t*)(ws + WS_U); cb = pn * 256; }
        else if (pn < 16) { act = 1; dst = (bf16_t*)(ws + WS_V); cb = (pn - 8) * 256; stats = true; }
        else if (pn < 24) { act = 0; dst = (bf16_t*)(ws + WS_SG); cb = (pn - 16) * 256; }
        else if (pn < 32) { act = 4; dst = (bf16_t*)(ws + WS_Q); cb = (pn - 24) * 256; }
        else if (pn < 44) { act = 0; const int j = (pn - 32) >> 1; store = (j < 2) ? 1 : ((j & 1) ? 2 : 4); dst = (bf16_t*)(ws + WS_KV) + (size_t)j * KV_SLAB; cb = ((pn - 32) & 1) * 2; }
        else if (pn < 52) { act = 0; dst = (bf16_t*)(ws + WS_SGB); cb = (pn - 44) * 256; }
        else if (pn < 60) { act = 0; dst = (bf16_t*)(ws + WS_XW); cb = (pn - 52) * 256; }
        else if (pn < 68) { act = 0; dst = (bf16_t*)(ws + WS_SGC); cb = (pn - 60) * 256; }
        else { act = 3; dst = (bf16_t*)(ws + WS_MG); cb = (pn - 68) * 256; ldc = 6144; }
        float* st = (float*)(ws + WS_STATP) + (size_t)(((pn - 8) & 7) * 4 + wc) * NTOK * 2;
#pragma unroll
        for (int ai = 0; ai < 2; ++ai)
#pragma unroll
            for (int m = 0; m < 4; ++m) {
                const int row = EPI_ROW(ai, m);
                float rs = 0.f, rq = 0.f;
#pragma unroll
                for (int bj = 0; bj < 2; ++bj) {
                    f32x4 v0 = acc[ai][bj][m][0], v1 = acc[ai][bj][m][1];
                    if (act == 1) {
#pragma unroll
                        for (int j = 0; j < 4; ++j) { v0[j] = gelu_f(v0[j]); v1[j] = gelu_f(v1[j]); }
                    } else if (act == 2) {
#pragma unroll
                        for (int j = 0; j < 4; ++j) { v0[j] = silu_f(v0[j]); v1[j] = silu_f(v1[j]); }
                    } else if (act == 3) {
#pragma unroll
                        for (int j = 0; j < 4; ++j) { v0[j] = sigmoid_f(v0[j]); v1[j] = sigmoid_f(v1[j]); }
                    } else if (act == 4) {
                        const float qs = 0.08838834764831845f * LOG2E;
                        v0 = v0 * qs; v1 = v1 * qs;
                    }
                    if (stats) {
#pragma unroll
                        for (int j = 0; j < 4; ++j) { rs += v0[j] + v1[j]; rq += v0[j] * v0[j] + v1[j] * v1[j]; }
                    }
                    const int colt = EPI_COLT(bj);
                    if (store == 0) {
                        __builtin_nontemporal_store(pack8(v0, v1), (u32x4*)(dst + (size_t)row * ldc + cb + colt));
                    } else if (store == 1) {
                        const int bb = row >> 11, t = row & 2047, g = cb + bj, d0 = wc * 32 + 8 * fq;
                        *(u32x4*)(dst + ((size_t)(bb * 4 + g) * 2048 + t) * 128 + d0) = pack8(v0, v1);
                    } else if (store == 4) {
                        const int bb = row >> 11, t = row & 2047, g = cb + bj, c = wc * 4 + fq;
                        *(u32x4*)(dst + ((((size_t)(bb * 4 + g) * 32 + (t >> 6)) * 16 + c) * 64 + (t & 63)) * 8) = pack8(v0, v1);
                    } else if (store == 2) {
                        const int bb = row >> 11, t = row & 2047, g = cb + bj, d0 = wc * 32 + 8 * fq;
                        bf16_t* pp = dst + ((((size_t)(bb * 4 + g) * 32 + (t >> 6)) * 8 + ((t & 63) >> 3)) * 128 + d0) * 8 + (t & 7);
                        const u32x4 w = pack8(v0, v1);
                        pp[0] = (bf16_t)(w.x & 0xffff); pp[8] = (bf16_t)(w.x >> 16); pp[16] = (bf16_t)(w.y & 0xffff); pp[24] = (bf16_t)(w.y >> 16);
                        pp[32] = (bf16_t)(w.z & 0xffff); pp[40] = (bf16_t)(w.z >> 16); pp[48] = (bf16_t)(w.w & 0xffff); pp[56] = (bf16_t)(w.w >> 16);
                    }
                }
                if (stats) {
                    { const int ln = fq * 16 + fr; rs += shfl_xor_l(rs, 16, ln); rs += shfl_xor_l(rs, 32, ln); rq += shfl_xor_l(rq, 16, ln); rq += shfl_xor_l(rq, 32, ln); }
                    if (fq == 0) { typedef float f32x2 __attribute__((ext_vector_type(2))); *(f32x2*)(st + (size_t)row * 2) = (f32x2){rs, rq}; }
                }
            }
    }
};
struct EpiFold {
    unsigned char* ws0;
    __device__ __forceinline__ void operator()(const AccT& acc, const Unit& u, int wr, int wc, int fr, int fq) const {
        unsigned char* ws = launder(ws0);
        const int l = u.z >> 2, gi = u.z & 3;
        bf16_t* dst = (bf16_t*)(ws + WS_WINT) + ((size_t)l * NPAD + 13312 + gi * 512) * 2048;
#pragma unroll
        for (int ai = 0; ai < 2; ++ai)
#pragma unroll
            for (int m = 0; m < 4; ++m)
#pragma unroll
                for (int bj = 0; bj < 2; ++bj)
                    *(u32x4*)(dst + (size_t)EPI_ROW(ai, m) * 2048 + u.pn * 256 + EPI_COLT(bj)) = pack8(acc[ai][bj][m][0], acc[ai][bj][m][1]);
    }
};
struct EpiCmp {
    unsigned char* ws0;
    __device__ __forceinline__ void operator()(const AccT& acc, const Unit& u, int wr, int wc, int fr, int fq) const {
        unsigned char* ws = launder(ws0);
        if (u.z < 2) {
            float* dst = (float*)(ws + WS_PQ) + (size_t)u.z * 4096 * 256;
#pragma unroll
            for (int ai = 0; ai < 2; ++ai)
#pragma unroll
                for (int m = 0; m < 4; ++m)
#pragma unroll
                    for (int bj = 0; bj < 2; ++bj) { float* pp = dst + (size_t)EPI_ROW(ai, m) * 256 + EPI_COLT(bj); *(f32x4*)pp = acc[ai][bj][m][0]; *(f32x4*)(pp + 4) = acc[ai][bj][m][1]; }
        } else {
            float* gs = (float*)(ws + WS_GS);
            const int colt = EPI_COLT(0);
            if (colt < 48) {
#pragma unroll
                for (int ai = 0; ai < 2; ++ai)
#pragma unroll
                    for (int m = 0; m < 4; ++m) { f32x4 v0 = acc[ai][0][m][0], v1 = acc[ai][0][m][1];
#pragma unroll
                        for (int j = 0; j < 4; ++j) { v0[j] = sigmoid_f(v0[j]); v1[j] = sigmoid_f(v1[j]); }
                        float* pp = gs + (size_t)EPI_ROW(ai, m) * 48 + colt; *(f32x4*)pp = v0; *(f32x4*)(pp + 4) = v1; }
            }
        }
    }
};
struct EpiBranch {
    unsigned char* ws0;
    __device__ __forceinline__ void operator()(const AccT& acc, const Unit& u, int wr, int wc, int fr, int fq) const {
        unsigned char* ws = launder(ws0);
        float* tmp = (float*)(ws + WS_H) + (size_t)blockIdx.x * 65536;
        const bf16_t* mg = (const bf16_t*)(ws + WS_MG);
        bf16_t* y = (bf16_t*)(ws + WS_V);
        const int x = u.z;
        if (x > 0) __builtin_amdgcn_fence(__ATOMIC_ACQUIRE, "agent");
#pragma unroll
        for (int ai = 0; ai < 2; ++ai)
#pragma unroll
            for (int mh = 0; mh < 2; ++mh) {
                u32x4 mw[2][2]; f32x4 t0[2][2], t1[2][2];
#pragma unroll
                for (int mm = 0; mm < 2; ++mm)
#pragma unroll
                    for (int bj = 0; bj < 2; ++bj) {
                        const int m = 2 * mh + mm, row = EPI_ROW(ai, m), rl = ai * 128 + wr * 64 + m * 16 + fr, colt = EPI_COLT(bj);
                        mw[mm][bj] = *(const u32x4*)(mg + (size_t)row * 6144 + x * 2048 + u.pn * 256 + colt);
                        if (x > 0) { const float* tp = tmp + rl * 256 + colt; t0[mm][bj] = *(const f32x4*)tp; t1[mm][bj] = *(const f32x4*)(tp + 4); }
                    }
#pragma unroll
                for (int mm = 0; mm < 2; ++mm)
#pragma unroll
                    for (int bj = 0; bj < 2; ++bj) {
                        const int m = 2 * mh + mm, row = EPI_ROW(ai, m), rl = ai * 128 + wr * 64 + m * 16 + fr, colt = EPI_COLT(bj);
                        const u32x4 w = mw[mm][bj];
                        f32x4 v0 = acc[ai][bj][m][0], v1 = acc[ai][bj][m][1];
                        v0[0] *= bf_lo(w.x); v0[1] *= bf_hi(w.x); v0[2] *= bf_lo(w.y); v0[3] *= bf_hi(w.y);
                        v1[0] *= bf_lo(w.z); v1[1] *= bf_hi(w.z); v1[2] *= bf_lo(w.w); v1[3] *= bf_hi(w.w);
                        if ((!EN_A && x == 0) || (!EN_B && x == 1) || (!EN_C && x == 2)) { v0 = v0 * 0.f; v1 = v1 * 0.f; }
                        float* tp = tmp + rl * 256 + colt;
                        if (x > 0) { v0 = v0 + t0[mm][bj]; v1 = v1 + t1[mm][bj]; }
                        if (x < 2) { *(f32x4*)tp = v0; *(f32x4*)(tp + 4) = v1; }
                        else *(u32x4*)(y + (size_t)row * 2048 + u.pn * 256 + colt) = pack8(v0, v1);
                    }
            }
    }
};
struct EpiOut {
    const float* xin0; float* xout0; const float* gate0;
    __device__ __forceinline__ void operator()(const AccT& acc, const Unit& u, int wr, int wc, int fr, int fq) const {
        const float* xin = launder(xin0); float* xout = launder(xout0); const float* gate = launder(gate0);
        const int bb = (u.pm * 256) >> 11;
        f32x4 g0[2], g1[2];
#pragma unroll
        for (int bj = 0; bj < 2; ++bj) { const int col = u.pn * 256 + EPI_COLT(bj); g0[bj] = *(const f32x4*)(gate + (size_t)bb * 6144 + col); g1[bj] = *(const f32x4*)(gate + (size_t)bb * 6144 + col + 4); }
#pragma unroll
        for (int ai = 0; ai < 2; ++ai)
            {
                constexpr int mh = 0;
                f32x4 x0[4][2], x1[4][2];
#pragma unroll
                for (int mm = 0; mm < 4; ++mm)
#pragma unroll
                    for (int bj = 0; bj < 2; ++bj) { const int row = EPI_ROW(ai, 2 * mh + mm), col = u.pn * 256 + EPI_COLT(bj);
                        x0[mm][bj] = *(const f32x4*)(xin + (size_t)row * 2048 + col); x1[mm][bj] = *(const f32x4*)(xin + (size_t)row * 2048 + col + 4); }
#pragma unroll
                for (int mm = 0; mm < 4; ++mm)
#pragma unroll
                    for (int bj = 0; bj < 2; ++bj) { const int m = 2 * mh + mm, row = EPI_ROW(ai, m), col = u.pn * 256 + EPI_COLT(bj);
                        *(f32x4*)(xout + (size_t)row * 2048 + col) = x0[mm][bj] + g0[bj] * acc[ai][bj][m][0];
                        *(f32x4*)(xout + (size_t)row * 2048 + col + 4) = x1[mm][bj] + g1[bj] * acc[ai][bj][m][1]; }
            }
    }
};

__device__ __forceinline__ void wave_transpose(const float* src, int lds_, int nvalid, bf16_t* dst, int ldd, int lane, LAS unsigned char* wl) {
    const bool ok = lane < nvalid;
    const float* s = src + lane;
    float v[64];
#pragma unroll
    for (int j = 0; j < 64; ++j) v[j] = ok ? s[(size_t)j * lds_] : 0.f;
#pragma unroll
    for (int c = 0; c < 8; ++c) {
        u32x4 o; o.x = cvt_pk_bf16(v[8 * c], v[8 * c + 1]); o.y = cvt_pk_bf16(v[8 * c + 2], v[8 * c + 3]); o.z = cvt_pk_bf16(v[8 * c + 4], v[8 * c + 5]); o.w = cvt_pk_bf16(v[8 * c + 6], v[8 * c + 7]);
        *(LAS u32x4*)(wl + lane * 144 + c * 16) = o;
    }
    asm volatile("s_waitcnt lgkmcnt(0)" ::: "memory");
#pragma unroll
    for (int j = 0; j < 8; ++j) {
        const int n = (lane >> 3) + 8 * j, c = lane & 7;
        const u32x4 o = *(const LAS u32x4*)(wl + n * 144 + c * 16);
        *(u32x4*)(dst + (size_t)n * ldd + c * 8) = o;
    }
    asm volatile("s_waitcnt lgkmcnt(0)" ::: "memory");
}

__device__ __forceinline__ void prep_phase(const KP p, LAS unsigned char* lds) {
    unsigned char* ws = launder(p->ws);
    const int tid = opaque_tid(), lane = tid & 63;
    constexpr int N_MOD = 192, N_B1 = 32, N_WCX = 64, N_WSM = 16, NBLK = N_MOD + N_B1 + N_WCX + N_WSM;
    for (int it = blockIdx.x; it < NBLK; it += gridDim.x) {
        int r = it;
        if (r < N_MOD) {
            const int l = r / 96, c0 = (r % 96) * 64;
            LAS float* sc = (LAS float*)lds;
            LAS float* red = sc + 8 * 2048;
            for (int e = tid; e < 8 * 2048; e += 512) sc[e] = silu_f(p->in[I_C][e]);
            block_sync();
            const int c4 = (tid & 15) * 4, ks = tid >> 4;
            f32x4 a[8];
#pragma unroll
            for (int b = 0; b < 8; ++b) a[b] = (f32x4){0.f, 0.f, 0.f, 0.f};
            const float* w = p->in[I_WADA] + (size_t)l * 2048 * 6144 + c0 + c4;
#pragma unroll 8
            for (int k = ks * 64; k < ks * 64 + 64; ++k) { const f32x4 wv = *(const f32x4*)(w + (size_t)k * 6144);
#pragma unroll
                for (int b = 0; b < 8; ++b) a[b] = a[b] + wv * sc[b * 2048 + k]; }
#pragma unroll
            for (int b = 0; b < 8; ++b) *(LAS f32x4*)(red + (ks * 8 + b) * 64 + c4) = a[b];
            block_sync();
            { const int b = tid >> 6, col = tid & 63; float s = p->in[I_BADA][(size_t)l * 6144 + c0 + col];
#pragma unroll 8
              for (int k2 = 0; k2 < 32; ++k2) s += red[(k2 * 8 + b) * 64 + col];
              ((float*)(ws + WS_MOD))[((size_t)l * 8 + b) * 6144 + c0 + col] = s; }
            block_sync();
            continue;
        } r -= N_MOD;
        if (r < N_B1) {
            LAS float* red = (LAS float*)lds;
            const int mi = r >> 3, part = r & 7, e = tid & 127, ks = tid >> 7; float s = 0.f;
            const float* pos = p->in[I_POSCMP] + (size_t)mi * 4096; const float* w1 = p->in[I_WCMP1] + (size_t)mi * 4096 * 128;
#pragma unroll 16
            for (int k = part * 512 + ks * 128; k < part * 512 + ks * 128 + 128; ++k) s += pos[k] * w1[(size_t)k * 128 + e];
            red[tid] = s; block_sync();
            if (tid < 128) ((float*)(ws + WS_B1P))[r * 128 + tid] = (red[tid] + red[tid + 128]) + (red[tid + 256] + red[tid + 384]);
            block_sync();
            continue;
        } r -= N_B1;
        if (r < N_WCX) {
            const int l = r >> 5, k0 = (r & 31) * 64;
#pragma unroll 4
            for (int e = tid; e < 64 * 512; e += 512) { const int k = k0 + (e >> 9), c4 = (e & 511) * 4;
                const f32x4 v = *(const f32x4*)(p->in[I_WIN] + (size_t)l * 2048 * NCOLS + (size_t)k * NCOLS + 13360 + c4);
                u32x2 o; o.x = cvt_pk_bf16(v[0], v[1]); o.y = cvt_pk_bf16(v[2], v[3]);
                *(u32x2*)((bf16_t*)(ws + WS_WCXN) + (size_t)l * 2048 * 2048 + (size_t)k * 2048 + c4) = o; }
            continue;
        } r -= N_WCX;
        {
            const float* srcp = p->in[I_AWS] + (size_t)r * 16384; bf16_t* dst = (bf16_t*)(ws + WS_WSM) + (size_t)r * 16384;
            for (int e = tid; e < 8192; e += 512) { const int t = (2 * e) >> 7, s = (2 * e) & 127;
                const float a = s <= t ? srcp[2 * e] : 0.f, b = (s + 1) <= t ? srcp[2 * e + 1] : 0.f;
                *(unsigned*)(dst + 2 * e) = cvt_pk_bf16(a, b); }
        }
    }
    constexpr int T_WIN = 2 * 340 * 32, T_WBR = 6 * 1024, T_WOUT = 2 * 1024, T_WGRP = 8 * 64, T_W1 = 4 * 128, T_W2 = 4 * 4;
    constexpr int T_TOTAL = T_WIN + T_WBR + T_WOUT + T_WGRP + T_W1 + T_W2;
    const int gw = blockIdx.x * 8 + (tid >> 6), nw = gridDim.x * 8;
    LAS unsigned char* wl = lds + (tid >> 6) * 9216;
    for (int it0 = gw; it0 < T_TOTAL; it0 += nw) {
        int r = __builtin_amdgcn_readfirstlane(it0);
        if (r < T_WIN) {
            const int l = r / (340 * 32); r -= l * 340 * 32; const int kt = r / 340; int nt = r - kt * 340; if (nt >= 208) nt += 32;
            const int n0 = nt * 64; int srcc, nvalid = 64;
            if (n0 < 11264) srcc = n0; else if (n0 < 23552) srcc = n0 + 48; else if (n0 == 23552) { srcc = 11264; nvalid = 48; } else { srcc = 0; nvalid = 0; }
            wave_transpose(p->in[I_WIN] + (size_t)l * 2048 * NCOLS + (size_t)kt * 64 * NCOLS + srcc, NCOLS, nvalid, (bf16_t*)(ws + WS_WINT) + ((size_t)l * NPAD + n0) * 2048 + kt * 64, 2048, lane, wl);
            continue;
        } r -= T_WIN;
        if (r < T_WBR) { const int mi = r >> 10; r &= 1023; const int kt = r >> 5, nt = r & 31;
            wave_transpose(p->in[I_WBR] + (size_t)mi * 2048 * 2048 + (size_t)kt * 64 * 2048 + nt * 64, 2048, 64, (bf16_t*)(ws + WS_WBRT) + (size_t)mi * 2048 * 2048 + (size_t)nt * 64 * 2048 + kt * 64, 2048, lane, wl); continue; } r -= T_WBR;
        if (r < T_WOUT) { const int mi = r >> 10; r &= 1023; const int kt = r >> 5, nt = r & 31;
            wave_transpose(p->in[I_WOUT] + (size_t)mi * 2048 * 2048 + (size_t)kt * 64 * 2048 + nt * 64, 2048, 64, (bf16_t*)(ws + WS_WOUTT) + (size_t)mi * 2048 * 2048 + (size_t)nt * 64 * 2048 + kt * 64, 2048, lane, wl); continue; } r -= T_WOUT;
        if (r < T_WGRP) { const int mi = r >> 6; r &= 63; const int kt = r >> 3, nt = r & 7;
            wave_transpose(p->in[I_CWGRP] + (size_t)mi * 512 * 512 + (size_t)kt * 64 * 512 + nt * 64, 512, 64, (bf16_t*)(ws + WS_WGRPT) + (size_t)mi * 512 * 512 + (size_t)nt * 64 * 512 + kt * 64, 512, lane, wl); continue; } r -= T_WGRP;
        if (r < T_W1) { const int mi = r >> 7; r &= 127; const int hh = r >> 6, kt = (r >> 1) & 31, nt = r & 1;
            wave_transpose(p->in[I_WCMP1] + (size_t)mi * 4096 * 128 + (size_t)(hh * 2048 + kt * 64) * 128 + nt * 64, 128, 64, (bf16_t*)(ws + WS_W1T) + (size_t)mi * 256 * 2048 + (size_t)(hh * 128 + nt * 64) * 2048 + kt * 64, 2048, lane, wl); continue; } r -= T_W1;
        { const int mi = r >> 2, kt = (r >> 1) & 1, nt = r & 1;
            wave_transpose(p->in[I_WCMP2] + (size_t)mi * 128 * 128 + (size_t)kt * 64 * 128 + nt * 64, 128, 64, (bf16_t*)(ws + WS_W2T) + (size_t)mi * 128 * 128 + (size_t)nt * 64 * 128 + kt * 64, 128, lane, wl); }
    }
}

__device__ __forceinline__ void rms_mod_phase(const float* x0, const float* g0, const float* mod0  , bf16_t* h0) {
    const float* x = launder(x0); const float* g = launder(g0); const float* mod = launder(mod0); bf16_t* h = launder(h0);
    const int tid_ = opaque_tid(); const int lane = tid_ & 63, gw = blockIdx.x * 8 + (tid_ >> 6), nw = gridDim.x * 8;
    for (int chunk = gw; chunk < NTOK / 8; chunk += nw) {
        const int row0 = chunk * 8;
        const float* mb = mod + (size_t)(row0 >> 11) * 6144;
        f32x4 gs[8], sh[8];
#pragma unroll
        for (int j = 0; j < 8; ++j) { const int c = 4 * (lane + 64 * j); gs[j] = *(const f32x4*)(g + c) * (*(const f32x4*)(mb + 2048 + c) + 1.f); sh[j] = *(const f32x4*)(mb + c); }
        f32x4 v[8], vn[8];
        { const f32x4* xr = (const f32x4*)(x + (size_t)row0 * D);
#pragma unroll
          for (int j = 0; j < 8; ++j) v[j] = xr[lane + 64 * j]; }
#pragma unroll 1
        for (int rr = 0; rr < 8; ++rr) {
            const int row = row0 + rr;
            if (rr < 7) { const f32x4* xr = (const f32x4*)(x + (size_t)(row + 1) * D);
#pragma unroll
                for (int j = 0; j < 8; ++j) vn[j] = xr[lane + 64 * j]; }
            float s = 0.f;
#pragma unroll
            for (int j = 0; j < 8; ++j) s += v[j][0] * v[j][0] + v[j][1] * v[j][1] + v[j][2] * v[j][2] + v[j][3] * v[j][3];
            s = wave_sum(s, lane);
            const float r = rsqrtf(s * (1.f / D) + 1e-6f);
#pragma unroll
            for (int j = 0; j < 8; ++j) {
                const f32x4 o = (v[j] * r) * gs[j] + sh[j];
                u32x2 w; w.x = cvt_pk_bf16(o[0], o[1]); w.y = cvt_pk_bf16(o[2], o[3]);
                *(u32x2*)(h + (size_t)row * D + 4 * (lane + 64 * j)) = w;
            }
#pragma unroll
            for (int j = 0; j < 8; ++j) v[j] = vn[j];
        }
    }
}
__device__ __forceinline__ void final_rms_phase(float* xo0, const float* g0) {
    float* xo = launder(xo0); const float* g = launder(g0);
    const int tid_ = opaque_tid(); const int lane = tid_ & 63, gw = blockIdx.x * 8 + (tid_ >> 6), nw = gridDim.x * 8;
    f32x4 gg[8];
#pragma unroll
    for (int j = 0; j < 8; ++j) gg[j] = *(const f32x4*)(g + 4 * (lane + 64 * j));
    f32x4 v[8], vn[8];
    if (gw < NTOK) { const f32x4* xr = (const f32x4*)(xo + (size_t)gw * D);
#pragma unroll
        for (int j = 0; j < 8; ++j) v[j] = xr[lane + 64 * j]; }
    for (int row = gw; row < NTOK; row += nw) {
        const int nrow = row + nw;
        if (nrow < NTOK) { const f32x4* xn = (const f32x4*)(xo + (size_t)nrow * D);
#pragma unroll
            for (int j = 0; j < 8; ++j) vn[j] = xn[lane + 64 * j]; }
        f32x4* xr = (f32x4*)(xo + (size_t)row * D);
        float s = 0.f;
#pragma unroll
        for (int j = 0; j < 8; ++j) s += v[j][0] * v[j][0] + v[j][1] * v[j][1] + v[j][2] * v[j][2] + v[j][3] * v[j][3];
        s = wave_sum(s, lane);
        const float r = rsqrtf(s * (1.f / D) + 1e-6f);
#pragma unroll
        for (int j = 0; j < 8; ++j) xr[lane + 64 * j] = (v[j] * r) * gg[j];
#pragma unroll
        for (int j = 0; j < 8; ++j) v[j] = vn[j];
    }
}

__device__ __forceinline__ void amix_item(const KP p, int layer, LAS unsigned char* lds, int item) {
    unsigned char* ws = launder(p->ws);
    const int tid = opaque_tid(), wave = tid >> 6, lane = tid & 63;
    const int g = item & 7, ch = (item >> 3) & 15, b = item >> 7;
    const int T0 = b * 2048 + ch * 128, c0 = g * 256;
    LAS unsigned char* VT = lds;
    LAS unsigned char* WS_ = lds + 65536;
    LAS float* MR = (LAS float*)(lds + 98304);
    const float* st = (const float*)(ws + WS_STATP);
    {
        typedef float f32x2v __attribute__((ext_vector_type(2)));
        LAS float* RED = (LAS float*)(lds + 99328);
        const int t = tid & 127, pg = tid >> 7;
        f32x2v pv[8];
#pragma unroll
        for (int k = 0; k < 8; ++k) pv[k] = *(const f32x2v*)(st + ((size_t)(pg * 8 + k) * NTOK + T0 + t) * 2);
        float s = 0.f, q = 0.f;
#pragma unroll
        for (int k = 0; k < 8; ++k) { s += pv[k][0]; q += pv[k][1]; }
        RED[(pg * 128 + t) * 2] = s; RED[(pg * 128 + t) * 2 + 1] = q;
    }
    { const bf16_t* wsm = (const bf16_t*)(ws + WS_WSM) + (size_t)(layer * 8 + g) * 16384;
#pragma unroll
      for (int i = 0; i < 4; ++i) { const int c = tid + 512 * i, row = c >> 4, chn = c & 15;
          *(LAS u32x4*)(WS_ + row * 256 + ((chn ^ (row & 15)) << 4)) = *(const u32x4*)(wsm + row * 128 + chn * 8); } }
    block_sync();
    if (tid < 128) { const LAS float* RED = (const LAS float*)(lds + 99328); float s = 0.f, q = 0.f;
#pragma unroll
        for (int k = 0; k < 4; ++k) { s += RED[(k * 128 + tid) * 2]; q += RED[(k * 128 + tid) * 2 + 1]; }
        const float mean = s * (1.f / 2048.f); const float var = fmaxf(q * (1.f / 2048.f) - mean * mean, 0.f);
        MR[tid * 2] = mean; MR[tid * 2 + 1] = rsqrtf(var + 1e-6f); }
    block_sync();
    { const bf16_t* V = (const bf16_t*)(ws + WS_V);
      const float* lng = p->in[I_ALNG] + (size_t)layer * 2048 + c0; const float* lnb = p->in[I_ALNB] + (size_t)layer * 2048 + c0;
#pragma unroll
      for (int i = 0; i < 4; ++i) {
          const int id = tid + 512 * i, cg8 = id & 31, tp = id >> 5;
          const u32x4 a = *(const u32x4*)(V + (size_t)(T0 + 2 * tp) * 2048 + c0 + cg8 * 8), bq = *(const u32x4*)(V + (size_t)(T0 + 2 * tp + 1) * 2048 + c0 + cg8 * 8);
          const float m0 = MR[4 * tp], r0 = MR[4 * tp + 1], m1 = MR[4 * tp + 2], r1 = MR[4 * tp + 3];
          const f32x4 g0 = *(const f32x4*)(lng + cg8 * 8), g1 = *(const f32x4*)(lng + cg8 * 8 + 4), b0 = *(const f32x4*)(lnb + cg8 * 8), b1 = *(const f32x4*)(lnb + cg8 * 8 + 4);
          const unsigned aw[4] = {a.x, a.y, a.z, a.w}, bw[4] = {bq.x, bq.y, bq.z, bq.w};
#pragma unroll
          for (int j = 0; j < 8; ++j) {
              const float gg = j < 4 ? g0[j & 3] : g1[j & 3], bb = j < 4 ? b0[j & 3] : b1[j & 3];
              const float x0 = (j & 1) ? bf_hi(aw[j >> 1]) : bf_lo(aw[j >> 1]), x1 = (j & 1) ? bf_hi(bw[j >> 1]) : bf_lo(bw[j >> 1]);
              const int c = cg8 * 8 + j;
              *(LAS unsigned*)(VT + c * 256 + (((tp >> 2) ^ ((c ^ (c >> 3)) & 15)) << 4) + (tp & 3) * 4) = cvt_pk_bf16((x0 - m0) * r0 * gg + bb, (x1 - m1) * r1 * gg + bb);
          }
      } }
    block_sync();
    f32x4 acc[2][8];
#pragma unroll
    for (int mi = 0; mi < 2; ++mi)
#pragma unroll
        for (int ni = 0; ni < 8; ++ni) acc[mi][ni] = (f32x4){0.f, 0.f, 0.f, 0.f};
    const int fr = lane & 15, fq = lane >> 4;
#pragma unroll
    for (int ks = 0; ks < 4; ++ks) {
        bf16x8 af[2];
#pragma unroll
        for (int mi = 0; mi < 2; ++mi) { const int c = wave * 32 + mi * 16 + fr; af[mi] = *(const LAS bf16x8*)(VT + c * 256 + (((4 * ks + fq) ^ ((c ^ (c >> 3)) & 15)) << 4)); }
#pragma unroll
        for (int ni = 0; ni < 8; ++ni) {
            if (ks <= (ni >> 1)) {
                const int t = ni * 16 + fr; const bf16x8 bfr = *(const LAS bf16x8*)(WS_ + t * 256 + (((4 * ks + fq) ^ (t & 15)) << 4));
#pragma unroll
                for (int mi = 0; mi < 2; ++mi) acc[mi][ni] = __builtin_amdgcn_mfma_f32_16x16x32_bf16(af[mi], bfr, acc[mi][ni], 0, 0, 0);
            }
        }
    }
    { bf16_t* U = (bf16_t*)(ws + WS_U); const bf16_t* SG = (const bf16_t*)(ws + WS_SG); const float* bs = p->in[I_ABS] + (size_t)(layer * 8 + g) * 128;
      u32x2 uu[8][2], sg[8][2]; float bsv[8];
#pragma unroll
      for (int ni = 0; ni < 8; ++ni) {
          const int t = ni * 16 + fr; bsv[ni] = bs[t];
#pragma unroll
          for (int mi = 0; mi < 2; ++mi) { const size_t off = (size_t)(T0 + t) * 2048 + c0 + wave * 32 + mi * 16 + 4 * fq; uu[ni][mi] = *(const u32x2*)(U + off); sg[ni][mi] = *(const u32x2*)(SG + off); }
      }
#pragma unroll
      for (int ni = 0; ni < 8; ++ni) {
          const int t = ni * 16 + fr;
#pragma unroll
          for (int mi = 0; mi < 2; ++mi) {
              const size_t off = (size_t)(T0 + t) * 2048 + c0 + wave * 32 + mi * 16 + 4 * fq;
              const f32x4 a = acc[mi][ni]; const u32x2 u2 = uu[ni][mi], s2 = sg[ni][mi]; const float bv = bsv[ni];
              u32x2 o; o.x = cvt_pk_bf16(gelu_f(bf_lo(u2.x)) * (a[0] + bv) * silu_f(bf_lo(s2.x)), gelu_f(bf_hi(u2.x)) * (a[1] + bv) * silu_f(bf_hi(s2.x)));
              o.y = cvt_pk_bf16(gelu_f(bf_lo(u2.y)) * (a[2] + bv) * silu_f(bf_lo(s2.y)), gelu_f(bf_hi(u2.y)) * (a[3] + bv) * silu_f(bf_hi(s2.y)));
              *(u32x2*)(U + off) = o;
          }
      } }
    block_sync();
}

template <int WSZ>
__device__ __forceinline__ void cpool_body(const bf16_t* XW, bf16_t* SGC, const f32x4 l0, const f32x4 l1, const int t0) {
    u32x4 xw[8 + WSZ - 1], gq[8];
#pragma unroll
    for (int j = 0; j < WSZ - 1; ++j) { const int u = t0 - (WSZ - 1) + j; xw[j] = u >= 0 ? *(const u32x4*)(XW + (size_t)u * 2048) : (u32x4){0u, 0u, 0u, 0u}; }
#pragma unroll
    for (int i = 0; i < 8; ++i) { xw[WSZ - 1 + i] = *(const u32x4*)(XW + (size_t)(t0 + i) * 2048); gq[i] = *(const u32x4*)(SGC + (size_t)(t0 + i) * 2048); }
    float sum[8];
#pragma unroll
    for (int j = 0; j < 8; ++j) sum[j] = 0.f;
#pragma unroll
    for (int j = 0; j < WSZ - 1; ++j) { const u32x4 w = xw[j];
        sum[0] += bf_lo(w.x); sum[1] += bf_hi(w.x); sum[2] += bf_lo(w.y); sum[3] += bf_hi(w.y); sum[4] += bf_lo(w.z); sum[5] += bf_hi(w.z); sum[6] += bf_lo(w.w); sum[7] += bf_hi(w.w); }
#pragma unroll
    for (int i = 0; i < 8; ++i) {
        const u32x4 w = xw[WSZ - 1 + i], g4 = gq[i], w2 = xw[i];
        const float xv[8] = {bf_lo(w.x), bf_hi(w.x), bf_lo(w.y), bf_hi(w.y), bf_lo(w.z), bf_hi(w.z), bf_lo(w.w), bf_hi(w.w)};
        const float gv[8] = {silu_f(bf_lo(g4.x)), silu_f(bf_hi(g4.x)), silu_f(bf_lo(g4.y)), silu_f(bf_hi(g4.y)), silu_f(bf_lo(g4.z)), silu_f(bf_hi(g4.z)), silu_f(bf_lo(g4.w)), silu_f(bf_hi(g4.w))};
        const float ov[8] = {bf_lo(w2.x), bf_hi(w2.x), bf_lo(w2.y), bf_hi(w2.y), bf_lo(w2.z), bf_hi(w2.z), bf_lo(w2.w), bf_hi(w2.w)};
        const float inv = 1.f / (float)min(t0 + i + 1, WSZ);
        float o[8];
#pragma unroll
        for (int j = 0; j < 8; ++j) { sum[j] += xv[j]; o[j] = (sum[j] * inv - xv[j]) * (j < 4 ? l0[j & 3] : l1[j & 3]) * gv[j]; sum[j] -= ov[j]; }
        u32x4 ow; ow.x = cvt_pk_bf16(o[0], o[1]); ow.y = cvt_pk_bf16(o[2], o[3]); ow.z = cvt_pk_bf16(o[4], o[5]); ow.w = cvt_pk_bf16(o[6], o[7]);
        *(u32x4*)(SGC + (size_t)(t0 + i) * 2048) = ow;
    }
}
__device__ __forceinline__ void cpool_item(const KP p, int layer, int item) {
    unsigned char* ws = launder(p->ws);
    const int tid_ = opaque_tid(); const int wave = tid_ >> 6, lane = tid_ & 63;
    const int gi = item & 3, tt = (item >> 2) & 15, b = item >> 6;
    const int c = gi * 512 + lane * 8;
    const bf16_t* XW = (const bf16_t*)(ws + WS_XW) + (size_t)b * 2048 * 2048 + c;
    bf16_t* SGC = (bf16_t*)(ws + WS_SGC) + (size_t)b * 2048 * 2048 + c;
    const float* ls = p->in[I_CSCALE] + (size_t)layer * 2048 + c;
    const f32x4 l0 = *(const f32x4*)ls, l1 = *(const f32x4*)(ls + 4);
    const int t0 = tt * 128 + wave * 16;
    for (int hf = 0; hf < 2; ++hf) {
        if (gi == 0) cpool_body<2>(XW, SGC, l0, l1, t0 + 8 * hf);
        else if (gi == 1) cpool_body<4>(XW, SGC, l0, l1, t0 + 8 * hf);
        else if (gi == 2) cpool_body<8>(XW, SGC, l0, l1, t0 + 8 * hf);
        else cpool_body<16>(XW, SGC, l0, l1, t0 + 8 * hf);
    }
}

#if EN_B
constexpr int A_KB = 0, A_VB = 32768, A_BT = 65536, A_IMPH = 67584, A_IMPF = 101376, A_SEL = 109824, A_UNI = 110080;
__device__ __forceinline__ int kperm(int r) { return (r & ~12) | ((r & 8) >> 1) | ((r & 4) << 1); }
__device__ __forceinline__ int t5_bucket(int n) { if (n < 16) return n; const int v = 16 + (int)(logf((float)n * (1.f / 16.f)) / 2.0794415416798357f * 16.f); return v < 31 ? v : 31; }
__device__ __forceinline__ bf16x8 pack_frag(const f32x16& v, int s2) {
    u32x4 w; w.x = cvt_pk_bf16(v[8 * s2 + 0], v[8 * s2 + 1]); w.y = cvt_pk_bf16(v[8 * s2 + 2], v[8 * s2 + 3]); w.z = cvt_pk_bf16(v[8 * s2 + 4], v[8 * s2 + 5]); w.w = cvt_pk_bf16(v[8 * s2 + 6], v[8 * s2 + 7]);
    return __builtin_bit_cast(bf16x8, w);
}
#define ZERO16 ((f32x16){0.f,0.f,0.f,0.f,0.f,0.f,0.f,0.f,0.f,0.f,0.f,0.f,0.f,0.f,0.f,0.f})

__device__ __forceinline__ void kcvc_item(const KP p, const int layer, const int bg, const int isel) {
    unsigned char* ws = launder(p->ws);
    const int tid = opaque_tid(), wave = __builtin_amdgcn_readfirstlane(tid >> 6), lane = tid & 63, r = lane & 31, h = lane >> 5;
    unsigned char* img = ws + WS_KCI + (size_t)bg * 32768;
    {
        const int nb = wave & 3, dh = wave >> 2;
        {
            const int n = nb * 32 + r;
            const float nmask = n < 127 ? 1.f : 0.f;
#pragma unroll
            for (int i = 0; i < 2; ++i) {
                if (i != isel) continue;
                const float* Pr = (const float*)(ws + WS_PQ) + (size_t)i * 4096 * 256 + (size_t)(bg * 128 + n) * 256;
                const float* b1 = (const float*)(ws + WS_BIAS1) + (layer * 2 + i) * 128;
                const bf16_t* w2 = (const bf16_t*)(ws + WS_W2T) + (size_t)(layer * 2 + i) * 16384;
                f32x16 a0 = ZERO16, a1 = ZERO16;
#pragma unroll
                for (int ks = 0; ks < 8; ++ks) {
                    const int e0 = 16 * ks + 8 * h;
                    const f32x4 pa = *(const f32x4*)(Pr + e0), pb = *(const f32x4*)(Pr + e0 + 4), qa = *(const f32x4*)(Pr + 384 + e0), qb = *(const f32x4*)(Pr + 384 + e0 + 4);
                    const f32x4 ba = *(const f32x4*)(b1 + e0), bb = *(const f32x4*)(b1 + e0 + 4);
                    f32x4 x0 = pa + qa + ba, x1 = pb + qb + bb;
#pragma unroll
                    for (int j = 0; j < 4; ++j) { x0[j] = gelu_f(x0[j]) * nmask; x1[j] = gelu_f(x1[j]) * nmask; }
                    const bf16x8 hf = __builtin_bit_cast(bf16x8, pack8(x0, x1));
                    const bf16x8 w0 = *(const bf16x8*)(w2 + (size_t)(dh * 64 + r) * 128 + e0), w1 = *(const bf16x8*)(w2 + (size_t)(dh * 64 + 32 + r) * 128 + e0);
                    if (i == 0) { a0 = __builtin_amdgcn_mfma_f32_32x32x16_bf16(w0, hf, a0, 0, 0, 0); a1 = __builtin_amdgcn_mfma_f32_32x32x16_bf16(w1, hf, a1, 0, 0, 0); }
                    else { a0 = __builtin_amdgcn_mfma_f32_32x32x16_bf16(hf, w0, a0, 0, 0, 0); a1 = __builtin_amdgcn_mfma_f32_32x32x16_bf16(hf, w1, a1, 0, 0, 0); }
                }
#pragma unroll
                for (int dbl = 0; dbl < 2; ++dbl) {
                    const f32x16& a = dbl ? a1 : a0;
#pragma unroll
                    for (int aa = 0; aa < 4; ++aa) {
                        u32x2 w; w.x = cvt_pk_bf16(a[4 * aa], a[4 * aa + 1]); w.y = cvt_pk_bf16(a[4 * aa + 2], a[4 * aa + 3]);
                        if (i == 0) { const int chunk = dh * 8 + dbl * 4 + aa; *(u32x2*)(img + chunk * 2048 + n * 16 + 8 * h) = w; }
                        else { const int d = dh * 64 + dbl * 32 + r, chunk = nb * 4 + aa; *(u32x2*)(img + 32 * 32768 + chunk * 2048 + d * 16 + 8 * h) = w; }
                    }
                }
            }
        }
    }
}
__device__ __forceinline__ void attn_item(const KP p, const int layer, LAS unsigned char* lds, const int b, const int g, const int qi) {
    unsigned char* ws = launder(p->ws);
    const int tid = opaque_tid(), wave = __builtin_amdgcn_readfirstlane(tid >> 6), lane = tid & 63, r = lane & 31, h = lane >> 5;
    const int hl = wave >> 1, head = g * 4 + hl, qh = wave & 1;
    const int t0 = qi * 64, ql = qh * 32 + r, tq = t0 + ql, bg = b * 4 + g;
    const size_t tok = (size_t)b * 2048 + tq;
    LAS float* BT = (LAS float*)(lds + A_BT);
    LAS float* IMPH = (LAS float*)(lds + A_IMPH);
    LAS float* IMPF = (LAS float*)(lds + A_IMPF);
    LAS unsigned* SEL = (LAS unsigned*)(lds + A_SEL);
    LAS unsigned* UNI = (LAS unsigned*)(lds + A_UNI);
#if defined(ATT_NO_CMP) || defined(ATT_NO_SEL)
    const bool dosel = false;
#else
    const bool dosel = qi >= 16;
#endif
    for (int e = tid; e < 4 * 64 * 33; e += 512) IMPH[e] = 0.f;
    if (tid < 64) SEL[tid] = dosel ? 0u : 0xffffffffu;
    if (tid == 64) UNI[0] = dosel ? 0u : 0xffffffffu;
    { const int hh = tid >> 7, dist = tid & 127; BT[tid] = p->in[I_RELB][t5_bucket(dist) * 16 + g * 4 + hh] * LOG2E; }
    bf16x8 qf[8];
    { const bf16_t* Qp = (const bf16_t*)(ws + WS_Q) + tok * 2048 + head * 128 + h * 8;
#pragma unroll
      for (int kk = 0; kk < 8; ++kk) qf[kk] = *(const bf16x8*)(Qp + kk * 16); }
#ifdef ATT_NO_CMP
    const int nblk = 0;
#else
    const int nblk = min(4, (4 * qi + 3 + 31) >> 5);
#endif
    { const bf16_t* kci = (const bf16_t*)(ws + WS_KCI) + (size_t)bg * 16384 + wave * 2048 + lane * 8;
#pragma unroll
      for (int i_ = 0; i_ < 4; ++i_) __builtin_amdgcn_global_load_lds((const unsigned*)(kci + i_ * 512), (LAS unsigned*)(lds + A_KB + (wave * 4 + i_) * 1024), 16, 0, 0);
#pragma unroll
      for (int i_ = 0; i_ < 4; ++i_) __builtin_amdgcn_global_load_lds((const unsigned*)(kci + (size_t)32 * 16384 + i_ * 512), (LAS unsigned*)(lds + A_VB + (wave * 4 + i_) * 1024), 16, 0, 0); }
    block_sync();
    const LAS float* BTh = BT + hl * 128;
    const int kcbase = kperm(r) * 16 + h * 2048, vbase = r * 16 + h * 2048, ktbase = kperm(r) * 16 + h * 1024;
    unsigned ofp[4][8];
    f32x16 oacc[4];
    {
        f32x16 sc[4];
        float mx = -1e30f;
#pragma unroll
        for (int kb = 0; kb < 4; ++kb) {
            sc[kb] = ZERO16;
            if (kb < nblk) {
#pragma unroll
                for (int kk = 0; kk < 8; ++kk) { const bf16x8 a = *(const LAS bf16x8*)(lds + A_KB + kcbase + kb * 512 + kk * 4096); sc[kb] = __builtin_amdgcn_mfma_f32_32x32x16_bf16(a, qf[kk], sc[kb], 0, 0, 0); }
                float bias[16];
#pragma unroll
                for (int i = 0; i < 16; ++i) { const int n = 32 * kb + 16 * (i >> 3) + 8 * h + (i & 7); const int dist = tq - (16 * n + 31); bias[i] = BTh[min(max(dist, 0), 127)]; }
#pragma unroll
                for (int i = 0; i < 16; ++i) asm volatile("" : "+v"(bias[i]));
#pragma unroll
                for (int i = 0; i < 16; ++i) {
                    const int n = 32 * kb + 16 * (i >> 3) + 8 * h + (i & 7);
                    const int dist = tq - (16 * n + 31);
                    const float s = dist >= 0 ? sc[kb][i] + bias[i] : -1e30f;
                    sc[kb][i] = s; mx = fmaxf(mx, s);
                }
            }
        }
        mx = fmaxf(mx, shfl_xor_l(mx, 32, lane));
        float l = 0.f;
#pragma unroll
        for (int kb = 0; kb < 4; ++kb) if (kb < nblk) {
#pragma unroll
            for (int i = 0; i < 16; ++i) { const float s = sc[kb][i]; const float pv = s > -1e29f ? __builtin_amdgcn_exp2f(s - mx) : 0.f; sc[kb][i] = pv; l += pv; }
        }
        l += shfl_xor_l(l, 32, lane);
        const float inv = l > 0.f ? 1.f / l : 0.f;
#pragma unroll
        for (int db = 0; db < 4; ++db) oacc[db] = ZERO16;
#pragma unroll
        for (int kb = 0; kb < 4; ++kb) if (kb < nblk) {
            sc[kb] = sc[kb] * inv;
            if (dosel) {
#pragma unroll
                for (int s2 = 0; s2 < 2; ++s2) {
                    LAS float* ip = IMPH + (hl * 64 + ql) * 33 + 8 * kb + 4 * s2 + 2 * h;
                    const float a = (sc[kb][8 * s2] + sc[kb][8 * s2 + 1]) + (sc[kb][8 * s2 + 2] + sc[kb][8 * s2 + 3]);
                    const float bq = ((sc[kb][8 * s2 + 4] + sc[kb][8 * s2 + 5]) + (sc[kb][8 * s2 + 6] + sc[kb][8 * s2 + 7])) + sc[kb][8 * s2 + 3];
                    __hip_atomic_fetch_add(ip, a, __ATOMIC_RELAXED, __HIP_MEMORY_SCOPE_WORKGROUP);
                    __hip_atomic_fetch_add(ip + 1, bq, __ATOMIC_RELAXED, __HIP_MEMORY_SCOPE_WORKGROUP);
                    __hip_atomic_fetch_add(ip + 2, sc[kb][8 * s2 + 7], __ATOMIC_RELAXED, __HIP_MEMORY_SCOPE_WORKGROUP);
                }
            }
#pragma unroll
            for (int s2 = 0; s2 < 2; ++s2) {
                const bf16x8 pf = pack_frag(sc[kb], s2);
#pragma unroll
                for (int db = 0; db < 4; ++db) { const bf16x8 a = *(const LAS bf16x8*)(lds + A_VB + vbase + (4 * kb + 2 * s2) * 2048 + db * 512); oacc[db] = __builtin_amdgcn_mfma_f32_32x32x16_bf16(a, pf, oacc[db], 0, 0, 0); }
            }
        }
        { const float g0 = ((const float*)(ws + WS_GS))[tok * 48 + head];
#pragma unroll
          for (int db = 0; db < 4; ++db) {
#pragma unroll
              for (int k = 0; k < 8; ++k) ofp[db][k] = cvt_pk_bf16(oacc[db][2 * k] * g0, oacc[db][2 * k + 1] * g0);
              oacc[db] = ZERO16; } }
    }
    block_sync();
    const bf16_t* KVp = (const bf16_t*)(ws + WS_KV);
    const unsigned ldoff = (unsigned)(wave * 1024 + lane * 8);
#define ATT_ISSUE(br_, s_, buf_) do { const bf16_t* Kt_ = KVp + (size_t)((br_) == 1 ? 2 : 4) * KV_SLAB + ((size_t)bg * 32 + (s_)) * 8192 + ldoff; \
        const bf16_t* Vt_ = KVp + (size_t)((br_) == 1 ? 3 : 5) * KV_SLAB + ((size_t)bg * 32 + (s_)) * 8192 + ldoff; \
        _Pragma("unroll") for (int i_ = 0; i_ < 2; ++i_) __builtin_amdgcn_global_load_lds((const unsigned*)(Kt_ + i_ * 512), (LAS unsigned*)(lds + A_KB + (buf_) * 16384 + (wave * 2 + i_) * 1024), 16, 0, 0); \
        _Pragma("unroll") for (int i_ = 0; i_ < 2; ++i_) __builtin_amdgcn_global_load_lds((const unsigned*)(Vt_ + i_ * 512), (LAS unsigned*)(lds + A_VB + (buf_) * 16384 + (wave * 2 + i_) * 1024), 16, 0, 0); } while (0)
    ATT_ISSUE(1, 0, 0);
    if (dosel) {
        const int q = tid >> 3, sg = tid & 7, tqq = t0 + q;
#pragma unroll
        for (int j = 0; j < 4; ++j) { const int s = sg * 4 + j;
            float v = (IMPH[(0 * 64 + q) * 33 + s] + IMPH[(1 * 64 + q) * 33 + s]) + (IMPH[(2 * 64 + q) * 33 + s] + IMPH[(3 * 64 + q) * 33 + s]);
            const bool fut = s * 64 > tqq, forced = (s == 0) || (s == qi) || (s == qi - 1);
            IMPF[q * 33 + s] = fut ? -1.f : (v + (forced ? 1e4f : 0.f)); }
        asm volatile("s_waitcnt lgkmcnt(0)" ::: "memory"); __builtin_amdgcn_s_barrier(); asm volatile("" ::: "memory");
        unsigned bits = 0;
        { float ov[32];
#pragma unroll
          for (int s2 = 0; s2 < 32; ++s2) ov[s2] = IMPF[q * 33 + s2];
#pragma unroll
          for (int j = 0; j < 4; ++j) { const int s = sg * 4 + j; const float v = IMPF[q * 33 + s]; int cnt = 0;
#pragma unroll
              for (int s2 = 0; s2 < 32; ++s2) cnt += (ov[s2] > v || (ov[s2] == v && s2 < s)) ? 1 : 0;
              if (cnt < 16) bits |= 1u << s; } }
        __hip_atomic_fetch_or(SEL + q, bits, __ATOMIC_RELAXED, __HIP_MEMORY_SCOPE_WORKGROUP);
        __hip_atomic_fetch_or(UNI, bits, __ATOMIC_RELAXED, __HIP_MEMORY_SCOPE_WORKGROUP);
    }
    block_sync();
    const unsigned selw = SEL[ql];
    const unsigned uni = (unsigned)__builtin_amdgcn_readfirstlane((int)UNI[0]);
    const unsigned causal_blocks = qi == 31 ? 0xffffffffu : ((2u << qi) - 1u);
    const float b31 = BTh[127];
    constexpr float MASKV = -30000.f, MINIT = -20000.f;
    float m = MINIT, l = 0.f;
    int br = 1, s = 0, buf = 0;
    while (br != 3) {
        int nbr, ns;
        if (br == 1) { const unsigned mk = uni & causal_blocks & ~((2u << s) - 1u); if (s < 31 && mk) { nbr = 1; ns = __builtin_ctz(mk); } else { nbr = 2; ns = max(0, qi - 8); } }
        else { if (s + 1 <= qi) { nbr = 2; ns = s + 1; } else { nbr = 3; ns = 0; } }
        if (nbr != 3) ATT_ISSUE(nbr, ns, buf ^ 1);
        const int kbase = s * 64;
        const bool need_elem = (kbase + 63 + 128 > t0) || (br == 2 && (t0 + 63 - kbase >= 512));
        const bool lanebit = br == 1 ? ((selw >> s) & 1u) != 0u : true;
        if (__builtin_amdgcn_ballot_w64(lanebit) != 0ull) {
        f32x16 sc[2];
        float mx = -1e30f;
        sc[0] = ZERO16; sc[1] = ZERO16;
        {
            const LAS unsigned char* kp = lds + A_KB + buf * 16384 + ktbase;
            bf16x8 ka[4][2];
#pragma unroll
            for (int kk = 0; kk < 4; ++kk) { ka[kk][0] = *(const LAS bf16x8*)(kp + kk * 2048); ka[kk][1] = *(const LAS bf16x8*)(kp + 512 + kk * 2048); }
#pragma unroll
            for (int kk = 0; kk < 8; ++kk) {
                sc[0] = __builtin_amdgcn_mfma_f32_32x32x16_bf16(ka[kk & 3][0], qf[kk], sc[0], 0, 0, 0);
                sc[1] = __builtin_amdgcn_mfma_f32_32x32x16_bf16(ka[kk & 3][1], qf[kk], sc[1], 0, 0, 0);
                if (kk < 4) { ka[kk][0] = *(const LAS bf16x8*)(kp + (kk + 4) * 2048); ka[kk][1] = *(const LAS bf16x8*)(kp + 512 + (kk + 4) * 2048); }
            }
        }
        float alpha, ls = 0.f;
        if (need_elem) {
            const int wlim = br == 1 ? 0x7fffffff : 512;
#pragma unroll
            for (int kb = 0; kb < 2; ++kb) {
                float bias[16];
#pragma unroll
                for (int i = 0; i < 16; ++i) { const int key = kbase + 32 * kb + 16 * (i >> 3) + 8 * h + (i & 7); bias[i] = BTh[min(max(tq - key, 0), 127)]; }
#pragma unroll
                for (int i = 0; i < 16; ++i) asm volatile("" : "+v"(bias[i]));
#pragma unroll
                for (int i = 0; i < 16; ++i) {
                    const int key = kbase + 32 * kb + 16 * (i >> 3) + 8 * h + (i & 7);
                    const int dist = tq - key;
                    const float sv = (lanebit && dist >= 0 && dist < wlim) ? sc[kb][i] + bias[i] : MASKV;
                    sc[kb][i] = sv; mx = fmaxf(mx, sv);
                }
            }
            mx = fmaxf(mx, shfl_xor_l(mx, 32, lane));
            const float mnew = fmaxf(m, mx);
            alpha = __builtin_amdgcn_exp2f(m - mnew);
            m = mnew;
#pragma unroll
            for (int kb = 0; kb < 2; ++kb)
#pragma unroll
                for (int i = 0; i < 16; ++i) { const float pv = __builtin_amdgcn_exp2f(sc[kb][i] - mnew); sc[kb][i] = pv; ls += pv; }
        } else {
            const float bl = lanebit ? b31 : MASKV;
#pragma unroll
            for (int kb = 0; kb < 2; ++kb)
#pragma unroll
                for (int i = 0; i < 16; ++i) mx = fmaxf(mx, sc[kb][i]);
            mx = fmaxf(mx, shfl_xor_l(mx, 32, lane));
            const float mnew = fmaxf(m, mx + bl);
            alpha = __builtin_amdgcn_exp2f(m - mnew);
            m = mnew;
            const float cc = bl - mnew;
#pragma unroll
            for (int kb = 0; kb < 2; ++kb)
#pragma unroll
                for (int i = 0; i < 16; ++i) { const float pv = __builtin_amdgcn_exp2f(sc[kb][i] + cc); sc[kb][i] = pv; ls += pv; }
        }
        l = l * alpha + ls;
        if (__builtin_amdgcn_ballot_w64(alpha != 1.f) != 0ull) {
#pragma unroll
            for (int db = 0; db < 4; ++db) oacc[db] = oacc[db] * alpha;
        }
        {
            const LAS unsigned char* vp = lds + A_VB + buf * 16384 + vbase;
            bf16x8 va[2][4];
#pragma unroll
            for (int gq = 0; gq < 2; ++gq)
#pragma unroll
                for (int db = 0; db < 4; ++db) va[gq][db] = *(const LAS bf16x8*)(vp + (2 * gq) * 2048 + db * 512);
#pragma unroll
            for (int gq = 0; gq < 4; ++gq) {
                const bf16x8 pf = pack_frag(sc[gq >> 1], gq & 1);
#pragma unroll
                for (int db = 0; db < 4; ++db) {
                    oacc[db] = __builtin_amdgcn_mfma_f32_32x32x16_bf16(va[gq & 1][db], pf, oacc[db], 0, 0, 0);
                    if (gq < 2) va[gq & 1][db] = *(const LAS bf16x8*)(vp + (2 * (gq + 2)) * 2048 + db * 512);
                }
            }
            __builtin_amdgcn_sched_group_barrier(0x100, 8, 0);
#pragma unroll
            for (int q_ = 0; q_ < 8; ++q_) { __builtin_amdgcn_sched_group_barrier(0x008, 1, 0); __builtin_amdgcn_sched_group_barrier(0x100, 1, 0); }
            __builtin_amdgcn_sched_group_barrier(0x008, 8, 0);
        }
        }
        if (nbr != br) {
            const float lt = l + shfl_xor_l(l, 32, lane);
            const float wgt = (lt > 0.f ? 1.f / lt : 0.f) * ((const float*)(ws + WS_GS))[tok * 48 + head + (br == 1 ? 16 : 32)];
#pragma unroll
            for (int db = 0; db < 4; ++db) {
#pragma unroll
                for (int k = 0; k < 8; ++k) ofp[db][k] = cvt_pk_bf16(bf_lo(ofp[db][k]) + oacc[db][2 * k] * wgt, bf_hi(ofp[db][k]) + oacc[db][2 * k + 1] * wgt);
                oacc[db] = ZERO16; }
            m = MINIT; l = 0.f;
        }
        block_sync();
        br = nbr; s = ns; buf ^= 1;
    }
    { const int tid2 = opaque_tid(); const int r2 = tid2 & 31, h2 = (tid2 >> 5) & 1;
      bf16_t* SGBp = (bf16_t*)(launder(p->ws) + WS_SGB) + ((size_t)b * 2048 + t0 + qh * 32 + r2) * 2048 + head * 128 + 4 * h2;
      u32x2 gq[4][4];
#pragma unroll
      for (int db = 0; db < 4; ++db)
#pragma unroll
          for (int aa = 0; aa < 4; ++aa) gq[db][aa] = *(const u32x2*)(SGBp + 32 * db + 8 * aa);
#pragma unroll
      for (int db = 0; db < 4; ++db)
#pragma unroll
          for (int aa = 0; aa < 4; ++aa) {
              bf16_t* po = SGBp + 32 * db + 8 * aa + (WS_XW - WS_SGB) / 2;
              const u32x2 g2 = gq[db][aa];
              u32x2 o; o.x = cvt_pk_bf16(bf_lo(ofp[db][2 * aa]) * silu_f(bf_lo(g2.x)), bf_hi(ofp[db][2 * aa]) * silu_f(bf_hi(g2.x))); o.y = cvt_pk_bf16(bf_lo(ofp[db][2 * aa + 1]) * silu_f(bf_lo(g2.y)), bf_hi(ofp[db][2 * aa + 1]) * silu_f(bf_hi(g2.y)));
              *(u32x2*)po = o;
          } }
#undef ATT_ISSUE
}
__device__ __forceinline__ void attn_phase(const KP p, int layer, LAS unsigned char* lds) {
    const int G = gridDim.x, c = blockIdx.x;
    for (int round = 0; round * G < 1024; ++round) {
        const int idx = round * G + ((round & 1) ? (G - 1 - c) : c);
        if (idx < 1024) { const int qi = 31 - (idx >> 5), bg = idx & 31; attn_item(p, layer, lds, bg >> 2, bg & 3, qi); }
    }
}
#endif


#define XB_TMO      128
#define XB_XCNT(j)  (256  + 64 * (j))
#define XB_XSUB(j)  (1280 + 64 * (j))
#define XB_XGEN(j)  (2304 + 64 * (j))
#define XB_TOP      3328
#define XB_TOPGEN   3392
#define XCD_BAR_WORDS 3456
#define XB_SPIN_CAP (1u << 20)
__device__ __forceinline__ unsigned xb_ld(unsigned* p)              { return __hip_atomic_load(p, __ATOMIC_RELAXED, __HIP_MEMORY_SCOPE_AGENT); }
__device__ __forceinline__ unsigned xb_add(unsigned* p, unsigned v) { return __hip_atomic_fetch_add(p, v, __ATOMIC_RELAXED, __HIP_MEMORY_SCOPE_AGENT); }
__device__ __forceinline__ unsigned xb_xcc_id() { return (unsigned)__builtin_amdgcn_s_getreg((3 << 11) | 20) & 0xFu; }
#define XB_SPIN(cond, bar) do { unsigned _sp = 0; while (cond) { __builtin_amdgcn_s_sleep(1); \
    if ((++_sp & 255u) == 0u) { if (xb_ld(&(bar)[XB_TMO])) break; if (_sp > XB_SPIN_CAP) { atomicAdd(&(bar)[XB_TMO], 1u); break; } } } } while (0)
struct XcdBarrier { unsigned* bar; unsigned x; volatile LAS unsigned* st; };
__device__ __forceinline__ XcdBarrier xcd_barrier_post(unsigned* bar, volatile LAS unsigned* st) {
    XcdBarrier b; b.bar = bar; b.x = xb_xcc_id(); b.st = st;
    if (opaque_tid() == 0) (void)xb_add(&bar[XB_XCNT(b.x)], 1u);
    return b;
}
__device__ __forceinline__ void xcd_barrier_complete(unsigned* bar, unsigned x, unsigned& nloc, unsigned& nx) {
    const unsigned G = gridDim.x * gridDim.y * gridDim.z;
    unsigned sum, cnt, mine, sp = 0u;
    for (;;) {
        sum = 0u; cnt = 0u; mine = 0u;
#pragma unroll
        for (unsigned j = 0; j < 16; ++j) { const unsigned c = xb_ld(&bar[XB_XCNT(j)]); sum += c; cnt += (c > 0u) ? 1u : 0u; mine = (j == x) ? c : mine; }
        if (sum == G) break;
        __builtin_amdgcn_s_sleep(1);
        if ((++sp & 255u) == 0u) { if (xb_ld(&bar[XB_TMO])) break; if (sp > XB_SPIN_CAP) { atomicAdd(&bar[XB_TMO], 1u); break; } }
    }
    nloc = mine > 0u ? mine : 1u; nx = cnt > 0u ? cnt : 1u;
}
__device__ __forceinline__ void xcd_barrier(const XcdBarrier& b) {
    asm volatile("s_waitcnt vmcnt(0)" ::: "memory");
    __syncthreads();
    if (opaque_tid() == 0) {
        unsigned* bar = b.bar;
        __builtin_amdgcn_s_waitcnt(0);
        unsigned nloc = b.st[0], nx = b.st[1];
        if (nloc == 0u) { xcd_barrier_complete(bar, b.x, nloc, nx); b.st[0] = nloc; b.st[1] = nx; }
        const unsigned old = xb_add(&bar[XB_XSUB(b.x)], 1u);
        const unsigned gen = old / nloc;
        if (old + 1u == (gen + 1u) * nloc) {
            __builtin_amdgcn_fence(__ATOMIC_RELEASE, "agent");
            asm volatile("s_waitcnt vmcnt(0)" ::: "memory");
            const unsigned og = xb_add(&bar[XB_TOP], 1u);
            const unsigned tg = og / nx;
            if (og + 1u == (tg + 1u) * nx) xb_add(&bar[XB_TOPGEN], 1u);
            else XB_SPIN(xb_ld(&bar[XB_TOPGEN]) == tg, bar);
            __builtin_amdgcn_fence(__ATOMIC_ACQUIRE, "agent");
            xb_add(&bar[XB_XGEN(b.x)], 1u);
            asm volatile("s_waitcnt vmcnt(0)" ::: "memory");
        } else {
            XB_SPIN(xb_ld(&bar[XB_XGEN(b.x)]) == gen, bar);
            __builtin_amdgcn_fence(__ATOMIC_ACQUIRE, "agent");
            asm volatile("s_waitcnt vmcnt(0)" ::: "memory");
        }
    }
    __syncthreads();
}

#define CG_SYNC() do { __builtin_amdgcn_fence(__ATOMIC_RELEASE, "agent"); grid.sync(); __builtin_amdgcn_fence(__ATOMIC_ACQUIRE, "agent"); } while (0)
#define GRID_SYNC() do { XcdBarrier xb_; xb_.bar = (unsigned*)(launder(p->ws) + WS_BAR); xb_.x = xb_xcc_id(); xb_.st = (volatile LAS unsigned*)(lds + 135168); xcd_barrier(xb_); } while (0)

__global__ void __launch_bounds__(512) mega(Params p_arg) {
    const KP p = (KP)__builtin_amdgcn_kernarg_segment_ptr();
    LAS unsigned char* lds = (LAS unsigned char*)lds_raw;
    { const int t0_ = threadIdx.x; if ((t0_ & 63) == 0) *(volatile LAS int*)(lds + TID_TAB_OFF + hw_slot() * 4) = t0_ >> 6; asm volatile("s_waitcnt lgkmcnt(0)" ::: "memory"); }
    cg::grid_group grid = cg::this_grid();
    unsigned char* ws = p->ws;
    const int G = gridDim.x, c = blockIdx.x;

#ifndef REP_PREP
#define REP_PREP 1
#endif
    unsigned* barw = (unsigned*)(ws + WS_BAR);
    volatile LAS unsigned* xst = (volatile LAS unsigned*)(lds + 135168);
    { const int t_ = opaque_tid(); if (t_ < 2) xst[t_] = 0u; }
    __syncthreads();
    (void)xcd_barrier_post(barw, xst);
    if (ws == nullptr) CG_SYNC();
    for (int rep = 0; rep < REP_PREP; ++rep) prep_phase(p, lds);
    GRID_SYNC();
    {
        if (c == G - 1) { const int t = opaque_tid(); const float* bp = (const float*)(ws + WS_B1P) + (size_t)(t >> 7) * 1024 + (t & 127); float s = 0.f;
#pragma unroll
            for (int q = 0; q < 8; ++q) s += bp[q * 128];
            ((float*)(ws + WS_BIAS1))[t] = s; }
        SchedFold S{(const char*)(ws + WS_WGRPT), (const char*)(ws + WS_WCXN), G, c};
        EpiFold E{ws};
#ifndef NO_FOLD
        pg8::gemm_phase(lds, 512, 512, 2048, S, E);
#endif
        rms_mod_phase(p->in[I_X], p->in[I_NORMG], (const float*)(ws + WS_MOD), (bf16_t*)(ws + WS_H));
    }
    GRID_SYNC();
    for (int layer = 0; layer < 2; ++layer) {
        {
            SchedStd S{(const char*)(ws + WS_H), (const char*)(ws + WS_WINT) + (size_t)layer * NPAD * 2048 * 2, 2048, 2048, 64, 92, 1, 0, 0, G, c};
            EpiMain E{ws, layer};
#ifndef REP_MAIN
#define REP_MAIN 1
#endif
            for (int rep = 0; rep < REP_MAIN; ++rep) pg8::gemm_phase(lds, 2048, 2048, 2048, S, E);
        }
        GRID_SYNC();
        {
#if EN_B
            SchedL3a S{(const char*)(ws + WS_KV), (const char*)(ws + WS_W1T) + (size_t)layer * 2 * 256 * 2048 * 2, (const char*)(ws + WS_H),
                       (const char*)(ws + WS_WINT) + ((size_t)layer * NPAD + 23552) * 2048 * 2, G, c};
            EpiCmp E{ws};
            pg8::gemm_phase(lds, 2048, 2048, 2048, S, E);
            if (c < 32) {
                __builtin_amdgcn_fence(__ATOMIC_ACQUIRE, "agent");
                kcvc_item(p, layer, 2 * (c & 15), c >> 4); kcvc_item(p, layer, 2 * (c & 15) + 1, c >> 4);
            }
#endif
#if EN_A
            if (G == 256) {
                if (c >= 96) { for (int k = 0; k < 5; ++k) amix_item(p, layer, lds, (c - 96) + 160 * k); }
                else if (c < 32) amix_item(p, layer, lds, 800 + c);
                else { for (int k = 0; k < 3; ++k) amix_item(p, layer, lds, 832 + (c - 32) + 64 * k); }
            } else for (int it = G - 1 - c; it < 1024; it += G) amix_item(p, layer, lds, it);
#endif
#if EN_C
            for (int it = c; it < 512; it += G) cpool_item(p, layer, it);
#endif
        }
        GRID_SYNC();
#if EN_B
#ifndef REP_ATT
#define REP_ATT 1
#endif
        for (int rep = 0; rep < REP_ATT; ++rep) attn_phase(p, layer, lds);
        GRID_SYNC();
#endif
        {
            SchedBranch S{(const char*)(ws + WS_U), (const char*)(ws + WS_XW), (const char*)(ws + WS_SGC), (const char*)(ws + WS_WBRT) + (size_t)layer * 3 * 2048 * 2048 * 2, G, c};
            EpiBranch E{ws};
#ifndef REP_BR
#define REP_BR 1
#endif
            for (int rep = 0; rep < REP_BR; ++rep) pg8::gemm_phase(lds, 2048, 2048, 2048, S, E);
        }
        GRID_SYNC();
        {
            SchedStd S{(const char*)(ws + WS_V), (const char*)(ws + WS_WOUTT) + (size_t)layer * 2048 * 2048 * 2, 2048, 2048, 64, 8, 1, 0, 0, G, c};
            EpiOut E{layer == 0 ? p->in[I_X] : (const float*)(ws + WS_XRES), layer == 0 ? (float*)(ws + WS_XRES) : p->out, (const float*)(ws + WS_MOD) + (size_t)layer * 8 * 6144 + 4096};
#ifndef REP_OUT
#define REP_OUT 1
#endif
            for (int rep = 0; rep < REP_OUT; ++rep) pg8::gemm_phase(lds, 2048, 2048, 2048, S, E);
        }
        GRID_SYNC();
        if (layer == 0) {
            rms_mod_phase((const float*)(ws + WS_XRES), p->in[I_NORMG] + 2048, (const float*)(ws + WS_MOD) + 8 * 6144, (bf16_t*)(ws + WS_H));
            GRID_SYNC();
        }
    }
#ifdef EXTRA_SYNCS
    for (int q = 0; q < EXTRA_SYNCS; ++q) GRID_SYNC();
#endif
    final_rms_phase(p->out, p->in[I_FINALG]);
}

extern "C" void kernel_launch(void* const* d_in, const int* in_sizes, int n_in, void* d_out, int out_size, void* d_ws, size_t ws_size, hipStream_t stream) {
    static int grid_blocks = 0;
    if (!grid_blocks) {
        int dev = 0, cus = 0, per_cu = 0;
        (void)hipGetDevice(&dev);
        (void)hipDeviceGetAttribute(&cus, hipDeviceAttributeMultiprocessorCount, dev);
        (void)hipFuncSetAttribute((const void*)mega, hipFuncAttributeMaxDynamicSharedMemorySize, LDS_BYTES);
        (void)hipOccupancyMaxActiveBlocksPerMultiprocessor(&per_cu, (const void*)mega, 512, LDS_BYTES);
        if (per_cu < 1) per_cu = 1;
        grid_blocks = cus * per_cu;
        if (ws_size < WS_END) fprintf(stderr, "workspace too small: %zu < %zu\n", ws_size, (size_t)WS_END);
    }
    Params p{};
    for (int i = 0; i < 19; ++i) p.in[i] = (const float*)d_in[i];
    p.out = (float*)d_out; p.ws = (unsigned char*)d_ws;
    (void)hipMemsetAsync((unsigned char*)d_ws + WS_BAR, 0, 16384, stream);
    void* args[] = {&p};
    hipError_t e = hipLaunchCooperativeKernel((void*)mega, dim3(grid_blocks), dim3(512), args, LDS_BYTES, stream);
    if (e != hipSuccess) fprintf(stderr, "cooperative launch failed: %s (grid %d)\n", hipGetErrorString(e), grid_blocks);
}
```
